# Optimizing an MI355X kernel written in HIP

```python
import jax, jax.numpy as jnp
from jax import lax
import numpy as np

D_MODEL = 1024
BATCH = 8
SEQ = 4096
DEPTH = 2

GRID_W = 64
CTX_LEN = 256

N_BRANCH = 4
BRANCH_W = D_MODEL // N_BRANCH
NA_HEADS = 4
NA_HEAD_DIM = BRANCH_W // NA_HEADS
NA_WIN_H = 8
NA_WIN_W = 16
GLA_HEADS = 4
GLA_DV = BRANCH_W // GLA_HEADS
GLA_DK = GLA_DV // 2
GLA_GATE_RANK = 16
GLA_TAU = 16.0
GLA_CHUNK = 64
ROPE_BASE = 100.0
CONV_CH = BRANCH_W
CONV_WIDTH = 31
SGU_CH = BRANCH_W
SGU_GROUPS = 4
SGU_CHUNK = 128
PEER_HEADS = 8
PEER_NKEYS = 128
PEER_N_EXPERTS = PEER_NKEYS * PEER_NKEYS
PEER_DQ = 256
PEER_TOPK = 16
PEER_TOK_BLOCK = 128
ALPHA = (2 * DEPTH) ** 0.25
BETA = (8 * DEPTH) ** -0.25
NEG_INF = -1e30
LN_EPS = 1e-6

W_IN_SIZES = (3 * BRANCH_W, GLA_HEADS * GLA_DK, GLA_HEADS * GLA_DK, GLA_HEADS * GLA_DV, GLA_HEADS * GLA_DV,
              2 * GLA_GATE_RANK, 2 * CONV_CH, 2 * SGU_CH, N_BRANCH * D_MODEL)
W_IN_COLS = sum(W_IN_SIZES)
W_IN_SPLITS = tuple(int(s) for s in np.cumsum(W_IN_SIZES)[:-1])

kernel_name = "hybrid_dit_natten_gla_conformer_sgu_peer"


def layer_norm(x, g, b):
    xf = x.astype(jnp.float32)
    mu = xf.mean(-1, keepdims=True)
    var = jnp.square(xf - mu).mean(-1, keepdims=True)
    return ((xf - mu) * lax.rsqrt(var + LN_EPS)).astype(x.dtype) * g + b


def axial_rope(x, row, col):
    half = x.shape[-1] // 2
    nf = half // 2
    inv = 1.0 / (ROPE_BASE ** (jnp.arange(nf, dtype=jnp.float32) / nf))

    def rot(xa, pos):
        ang = pos.astype(jnp.float32)[:, None] * inv[None, :]
        cos = jnp.cos(ang)[None, :, None, :].astype(x.dtype)
        sin = jnp.sin(ang)[None, :, None, :].astype(x.dtype)
        x1, x2 = xa[..., :nf], xa[..., nf:]
        return jnp.concatenate([x1 * cos - x2 * sin, x1 * sin + x2 * cos], axis=-1)

    return jnp.concatenate([rot(x[..., :half], row), rot(x[..., half:], col)], axis=-1)


def neighbourhood_attention(qkv, qkv_c, rpb, need_ctx):
    B, T, _ = qkv.shape
    L = qkv_c.shape[1]
    rows = T // GRID_W
    kh = min(NA_WIN_H, rows)
    H, dh = NA_HEADS, NA_HEAD_DIM
    scale = dh ** -0.5
    q, k, v = [t.reshape(B, rows, GRID_W, H, dh) for t in jnp.split(qkv, 3, axis=-1)]
    qc, kc, vc = [t.reshape(B, L, H, dh) for t in jnp.split(qkv_c, 3, axis=-1)]
    r = jnp.arange(rows)
    r0 = jnp.clip(r - kh // 2, 0, rows - kh)
    key_rows = r0[:, None] + jnp.arange(kh)[None, :]
    kb = k[:, key_rows]
    vb = v[:, key_rows]
    colv = jnp.arange(GRID_W)
    c0 = jnp.clip(colv - NA_WIN_W // 2, 0, GRID_W - NA_WIN_W)
    in_win = (colv[None, :] >= c0[:, None]) & (colv[None, :] < c0[:, None] + NA_WIN_W)
    dr = key_rows - r[:, None] + NA_WIN_H - 1
    dc = jnp.clip(colv[None, :] - colv[:, None], -(NA_WIN_W - 1), NA_WIN_W - 1) + NA_WIN_W - 1
    bias = rpb[:, dr[:, None, :, None], dc[None, :, None, :]]
    s_win = jnp.einsum('brqhd,brkwhd->bhrqkw', q, kb).astype(jnp.float32) * scale + bias[None].astype(jnp.float32)
    s_win = jnp.where(in_win[:, None, :], s_win, NEG_INF)
    s_ctx = jnp.einsum('brqhd,blhd->bhrql', q, kc).astype(jnp.float32) * scale
    nwin = kh * GRID_W
    p = jax.nn.softmax(jnp.concatenate([s_win.reshape(B, H, rows, GRID_W, nwin), s_ctx], axis=-1), axis=-1).astype(v.dtype)
    p_win = p[..., :nwin].reshape(B, H, rows, GRID_W, kh, GRID_W)
    p_ctx = p[..., nwin:]
    o = jnp.einsum('bhrqkw,brkwhd->brqhd', p_win, vb) + jnp.einsum('bhrql,blhd->brqhd', p_ctx, vc)
    y = o.reshape(B, T, H * dh)
    if need_ctx:
        s_cc = jnp.einsum('blhd,bmhd->bhlm', qc, kc).astype(jnp.float32) * scale
        oc = jnp.einsum('bhlm,bmhd->blhd', jax.nn.softmax(s_cc, axis=-1).astype(vc.dtype), vc)
        yc = oc.reshape(B, L, H * dh)
    else:
        yc = None
    return y, yc


def gla_chunked(q, k, v, log_a, s0):
    B, T, H, dk = q.shape
    C = GLA_CHUNK
    N = T // C

    def chunks(t):
        return t.astype(jnp.float32).reshape(B, N, C, H, t.shape[-1]).transpose(0, 3, 1, 2, 4)

    qf, kf, vf, la = chunks(q), chunks(k), chunks(v), chunks(log_a)
    b = jnp.cumsum(la, axis=3)
    b_last = b[:, :, :, -1:]
    q_s = qf * jnp.exp(b)
    k_s = kf * jnp.exp(-b)
    k_end = kf * jnp.exp(b_last - b)
    lower = jnp.tril(jnp.ones((C, C), dtype=bool))
    a_intra = jnp.where(lower, jnp.einsum('bhncd,bhnsd->bhncs', q_s, k_s), 0.0)
    o_intra = jnp.einsum('bhncs,bhnse->bhnce', a_intra, vf)
    u = jnp.einsum('bhncd,bhnce->bhnde', k_end, vf)
    decay = jnp.exp(b_last[:, :, :, 0])

    def step(s, inp):
        d, un = inp
        return d[..., None] * s + un, s

    s_final, s_prev = lax.scan(step, s0, (decay.transpose(2, 0, 1, 3), u.transpose(2, 0, 1, 3, 4)))
    s_prev = s_prev.transpose(1, 2, 0, 3, 4)
    o = o_intra + jnp.einsum('bhncd,bhnde->bhnce', q_s, s_prev)
    return o.transpose(0, 2, 3, 1, 4).reshape(B, T, H, v.shape[-1]), s_final


def _gla_prep(q, k, v, lo, gate_up, gate_b):
    B, T, _ = q.shape
    q = q.reshape(B, T, GLA_HEADS, GLA_DK) * GLA_DK ** -0.5
    k = k.reshape(B, T, GLA_HEADS, GLA_DK)
    v = v.reshape(B, T, GLA_HEADS, GLA_DV)
    lo_f, lo_b = jnp.split(lo, 2, axis=-1)

    def log_gate(l, d):
        logits = (l @ gate_up[d] + gate_b[d]).astype(jnp.float32)
        return (jax.nn.log_sigmoid(logits) / GLA_TAU).reshape(B, T, GLA_HEADS, GLA_DK)

    return q, k, v, log_gate(lo_f, 0), log_gate(lo_b, 1)


def _gla_out(o, r, norm_g):
    B, T = o.shape[:2]
    o = o * lax.rsqrt(jnp.mean(jnp.square(o), axis=-1, keepdims=True) + LN_EPS) * norm_g
    return o.reshape(B, T, GLA_HEADS * GLA_DV).astype(r.dtype) * jax.nn.silu(r)


def gla_branch(zl, zc, gate_up, gate_b, norm_g, row, col, need_ctx):
    ql, kl, vl, lfl, lbl = _gla_prep(zl[0], zl[1], zl[2], zl[4], gate_up, gate_b)
    ql, kl = axial_rope(ql, row, col), axial_rope(kl, row, col)
    qc, kc, vc, lfc, lbc = _gla_prep(zc[0], zc[1], zc[2], zc[4], gate_up, gate_b)
    s0 = jnp.zeros((ql.shape[0], GLA_HEADS, GLA_DK, GLA_DV), jnp.float32)

    def flip(t):
        return jnp.flip(t, axis=1)

    oc_f, sc_f = gla_chunked(qc, kc, vc, lfc, s0)
    oc_b, sc_b = gla_chunked(flip(qc), flip(kc), flip(vc), flip(lbc), s0)
    ol_f, _ = gla_chunked(ql, kl, vl, lfl, sc_f)
    ol_b, _ = gla_chunked(flip(ql), flip(kl), flip(vl), flip(lbl), sc_b)
    y = _gla_out(ol_f + flip(ol_b), zl[3], norm_g)
    yc = _gla_out(oc_f + flip(oc_b), zc[3], norm_g) if need_ctx else None
    return y, yc


def conformer_conv(z, dw, b, ln_g, ln_b):
    a, g = jnp.split(z, 2, axis=-1)
    y = a * jax.nn.sigmoid(g)
    y = lax.conv_general_dilated(y, dw[:, None, :], window_strides=(1,),
                                 padding=[(CONV_WIDTH // 2, CONV_WIDTH // 2)],
                                 dimension_numbers=('NWC', 'WIO', 'NWC'),
                                 feature_group_count=CONV_CH) + b
    return jax.nn.silu(layer_norm(y, ln_g, ln_b))


def spatial_gating(z, ln_g, ln_b, ws, bs):
    z = jax.nn.gelu(z)
    u, v = jnp.split(z, 2, axis=-1)
    v = layer_norm(v, ln_g, ln_b)
    B, T, _ = v.shape
    vb = v.reshape(B, T // SGU_CHUNK, SGU_CHUNK, SGU_GROUPS, SGU_CH // SGU_GROUPS)
    s = jnp.einsum('gpq,bnqgc->bnpgc', ws, vb) + bs.T[None, None, :, :, None]
    return u * s.reshape(B, T, SGU_CH)


def merge_branches(ys, gates, w_branch, w_out):
    merged = None
    for i in range(N_BRANCH):
        term = jax.nn.sigmoid(gates[..., i * D_MODEL:(i + 1) * D_MODEL]) * (ys[i] @ w_branch[i])
        merged = term if merged is None else merged + term
    return merged @ w_out


def token_mixer(h, hc, row, col, need_ctx, w_in, na_rpb, gla_gate_up, gla_gate_b, gla_norm_g,
                conv_dw, conv_b, conv_ln_g, conv_ln_b, sgu_ln_g, sgu_ln_b, sgu_ws, sgu_bs, w_branch, w_out):
    z = jnp.split(h @ w_in, W_IN_SPLITS, axis=-1)
    zc = jnp.split(hc @ w_in, W_IN_SPLITS, axis=-1)
    y_na, yc_na = neighbourhood_attention(z[0], zc[0], na_rpb, need_ctx)
    y_gla, yc_gla = gla_branch(z[1:6], zc[1:6], gla_gate_up, gla_gate_b, gla_norm_g, row, col, need_ctx)
    y_cv = conformer_conv(z[6], conv_dw, conv_b, conv_ln_g, conv_ln_b)
    y_sg = spatial_gating(z[7], sgu_ln_g, sgu_ln_b, sgu_ws, sgu_bs)
    y = merge_branches((y_na, y_gla, y_cv, y_sg), z[8], w_branch, w_out)
    if need_ctx:
        yc_cv = conformer_conv(zc[6], conv_dw, conv_b, conv_ln_g, conv_ln_b)
        yc_sg = spatial_gating(zc[7], sgu_ln_g, sgu_ln_b, sgu_ws, sgu_bs)
        yc = merge_branches((yc_na, yc_gla, yc_cv, yc_sg), zc[8], w_branch, w_out)
    else:
        yc = None
    return y, yc


def peer_ffn(h, wq, keys, u_tab, v_tab):
    B, T, D = h.shape
    tok = h.reshape(-1, PEER_TOK_BLOCK, D)
    K = PEER_TOPK

    def block(xb):
        P = xb.shape[0]
        q = (xb @ wq).reshape(P, PEER_HEADS, 2, PEER_DQ // 2)
        s = jnp.einsum('phsd,hskd->phsk', q, keys).astype(jnp.float32)
        top_s, top_i = lax.top_k(s, K)
        cand_s = (top_s[:, :, 0, :, None] + top_s[:, :, 1, None, :]).reshape(P, PEER_HEADS, K * K)
        cand_i = (top_i[:, :, 0, :, None] * PEER_NKEYS + top_i[:, :, 1, None, :]).reshape(P, PEER_HEADS, K * K)
        best_s, best_j = lax.top_k(cand_s, K)
        idx = jnp.take_along_axis(cand_i, best_j, axis=-1)
        g = jax.nn.softmax(best_s, axis=-1).astype(xb.dtype)
        a = jax.nn.gelu(jnp.einsum('pd,phkd->phk', xb, u_tab[idx]))
        return jnp.einsum('phk,phkd->pd', g * a, v_tab[idx])

    return lax.map(block, tok).reshape(B, T, D)


def setup_inputs(seed: int = 0) -> dict:
    key = jax.random.key(seed)
    ks = iter(jax.random.split(key, 40))
    D, L = D_MODEL, DEPTH

    def nrm(shape, scale):
        return jax.random.normal(next(ks), shape, jnp.float32) * scale

    return {
        "x": nrm((BATCH, SEQ, D), 1.0),
        "c": nrm((BATCH, D), 1.0),
        "ctx": nrm((BATCH, CTX_LEN, D), 1.0),
        "c_ctx": nrm((D,), 1.0),
        "ada_w": nrm((L, D, 6 * D), 0.5 * D ** -0.5),
        "ada_b": nrm((L, 6 * D), 0.02),
        "w_in": nrm((L, D, W_IN_COLS), D ** -0.5),
        "na_rpb": nrm((L, NA_HEADS, 2 * NA_WIN_H - 1, 2 * NA_WIN_W - 1), 0.1),
        "gla_gate_up": nrm((L, 2, GLA_GATE_RANK, GLA_HEADS * GLA_DK), GLA_GATE_RANK ** -0.5),
        "gla_gate_b": nrm((L, 2, GLA_HEADS * GLA_DK), 0.1),
        "gla_norm_g": 1.0 + nrm((L, GLA_HEADS, GLA_DV), 0.02),
        "conv_dw": nrm((L, CONV_WIDTH, CONV_CH), CONV_WIDTH ** -0.5),
        "conv_b": nrm((L, CONV_CH), 0.02),
        "conv_ln_g": 1.0 + nrm((L, CONV_CH), 0.02),
        "conv_ln_b": nrm((L, CONV_CH), 0.02),
        "sgu_ln_g": 1.0 + nrm((L, SGU_CH), 0.02),
        "sgu_ln_b": nrm((L, SGU_CH), 0.02),
        "sgu_ws": nrm((L, SGU_GROUPS, SGU_CHUNK, SGU_CHUNK), 0.5 * SGU_CHUNK ** -0.5),
        "sgu_bs": 1.0 + nrm((L, SGU_GROUPS, SGU_CHUNK), 0.02),
        "w_branch": nrm((L, N_BRANCH, BRANCH_W, D), BRANCH_W ** -0.5),
        "w_out": nrm((L, D, D), BETA * D ** -0.5),
        "ln1_g": 1.0 + nrm((L, D), 0.02),
        "ln1_b": nrm((L, D), 0.02),
        "peer_wq": nrm((L, D, PEER_HEADS * PEER_DQ), D ** -0.5),
        "peer_keys": nrm((L, PEER_HEADS, 2, PEER_NKEYS, PEER_DQ // 2), (PEER_DQ // 2) ** -0.5),
        "peer_u": nrm((L, PEER_N_EXPERTS, D), D ** -0.5),
        "peer_v": nrm((L, PEER_N_EXPERTS, D), BETA),
        "ln2_g": 1.0 + nrm((L, D), 0.02),
        "ln2_b": nrm((L, D), 0.02),
    }


def reference(x, c, ctx, c_ctx, ada_w, ada_b, w_in, na_rpb, gla_gate_up, gla_gate_b, gla_norm_g,
              conv_dw, conv_b, conv_ln_g, conv_ln_b, sgu_ln_g, sgu_ln_b, sgu_ws, sgu_bs, w_branch, w_out,
              ln1_g, ln1_b, peer_wq, peer_keys, peer_u, peer_v, ln2_g, ln2_b):
    T = x.shape[1]
    t = jnp.arange(T)
    row, col = t // GRID_W, t % GRID_W
    c_silu = jax.nn.silu(c)
    cc_silu = jax.nn.silu(c_ctx)
    xc = ctx
    for l in range(DEPTH):
        need_ctx = l < DEPTH - 1
        mod = c_silu @ ada_w[l] + ada_b[l]
        mod_c = cc_silu @ ada_w[l] + ada_b[l]
        sh1, sc1, g1, sh2, sc2, g2 = [m[:, None, :] for m in jnp.split(mod, 6, axis=-1)]
        sh1c, sc1c, g1c, sh2c, sc2c, g2c = jnp.split(mod_c, 6, axis=-1)
        h = x * (1 + sc1) + sh1
        hc = xc * (1 + sc1c) + sh1c
        y, yc = token_mixer(h, hc, row, col, need_ctx, w_in[l], na_rpb[l], gla_gate_up[l], gla_gate_b[l],
                            gla_norm_g[l], conv_dw[l], conv_b[l], conv_ln_g[l], conv_ln_b[l], sgu_ln_g[l],
                            sgu_ln_b[l], sgu_ws[l], sgu_bs[l], w_branch[l], w_out[l])
        x = layer_norm(ALPHA * x + g1 * y, ln1_g[l], ln1_b[l])
        h2 = x * (1 + sc2) + sh2
        x = layer_norm(ALPHA * x + g2 * peer_ffn(h2, peer_wq[l], peer_keys[l], peer_u[l], peer_v[l]), ln2_g[l], ln2_b[l])
        if need_ctx:
            xc = layer_norm(ALPHA * xc + g1c * yc, ln1_g[l], ln1_b[l])
            h2c = xc * (1 + sc2c) + sh2c
            xc = layer_norm(ALPHA * xc + g2c * peer_ffn(h2c, peer_wq[l], peer_keys[l], peer_u[l], peer_v[l]), ln2_g[l], ln2_b[l])
    return x
```

```cpp
#include <hip/hip_runtime.h>
#include <hip/hip_cooperative_groups.h>
#include <cstdio>
#include <cstdint>
namespace cg = cooperative_groups;

#define LAS __attribute__((address_space(3)))
typedef unsigned short bf16_t;
typedef short bf16x8 __attribute__((ext_vector_type(8)));
typedef float f32x4 __attribute__((ext_vector_type(4)));
typedef float f32x2 __attribute__((ext_vector_type(2)));
typedef unsigned u32x4 __attribute__((ext_vector_type(4)));
typedef unsigned u32x2 __attribute__((ext_vector_type(2)));

constexpr int NT = 512;
constexpr int M_LAT = 32768, M_CTX = 2048, M_ALL = 34816, DM = 1024;
constexpr int SEQ = 4096, CTXL = 256;
constexpr int WIN_COLS = 6688;
constexpr int ZP = 2816;
constexpr int ZQ = 0, ZK = 256, ZV = 512, ZGQ = 768, ZGK = 896, ZGV = 1024, ZGR = 1280, ZLO = 1536, ZCA = 1568, ZCG = 1824, ZSU = 2080, ZSV = 2336, ZGATE = 2592;
constexpr float ALPHA = 1.41421356237309515f;
constexpr float LN_EPS = 1e-6f;

constexpr size_t MiB = 1u << 20;
constexpr size_t W_WIN = 0, W_WG = 5767168, W_WB = W_WG + 8388608, W_WO = W_WB + 2097152, W_WS = W_WO + 2097152, W_LAYER = W_WS + 4194304;
constexpr size_t WS_W = 0;
constexpr size_t WS_MOD = 44 * MiB;
constexpr size_t WS_H = 46 * MiB;
constexpr size_t WS_Y = 114 * MiB;
constexpr size_t WS_XC = 182 * MiB;
constexpr size_t WS_BIG = 190 * MiB;
constexpr size_t B_Z = WS_BIG;
constexpr size_t B_AF = WS_BIG + 187 * MiB;
constexpr size_t B_AB = B_AF + 17 * MiB;
constexpr size_t B_QP = B_AB + 17 * MiB;
constexpr size_t B_KP = B_QP + 17 * MiB / 2;
constexpr size_t B_OF = B_KP + 17 * MiB / 2;
constexpr size_t B_OB = B_OF + 17 * MiB;
constexpr size_t B_VN = B_OB + 17 * MiB;
constexpr size_t B_P = WS_BIG;
constexpr size_t B_S = WS_BIG;
constexpr size_t B_TU = WS_BIG + 136 * MiB;
constexpr size_t B_TV = B_TU + 32 * MiB;
constexpr size_t WS_NEED = WS_BIG + 323 * MiB;

__device__ __forceinline__ float bf2f(bf16_t v) { return __uint_as_float((unsigned)v << 16); }
__device__ __forceinline__ unsigned f2bf(float f) { unsigned u = __float_as_uint(f); return (u + 0x7fffu + ((u >> 16) & 1u)) >> 16; }
__device__ __forceinline__ unsigned pk2(float lo, float hi) { return f2bf(lo) | (f2bf(hi) << 16); }
__device__ __forceinline__ float lo16(unsigned u) { return __uint_as_float(u << 16); }
__device__ __forceinline__ float hi16(unsigned u) { return __uint_as_float(u & 0xffff0000u); }
__device__ __forceinline__ float sigmoidf_(float x) { return 1.f / (1.f + __expf(-x)); }
__device__ __forceinline__ float siluf_(float x) { return x / (1.f + __expf(-x)); }
__device__ __forceinline__ float gelu_tanh(float x) { const float y = 0.7978845608028654f * (x + 0.044715f * x * x * x); const float t = 1.f - 2.f / (__expf(2.f * y) + 1.f); return 0.5f * x * (1.f + t); }
__device__ __forceinline__ float wave_sum(float v) {
#pragma unroll
    for (int o = 1; o < 64; o <<= 1) v += __shfl_xor(v, o);
    return v;
}
__device__ __forceinline__ void wave_sync() { __builtin_amdgcn_fence(__ATOMIC_RELEASE, "wavefront"); __builtin_amdgcn_wave_barrier(); __builtin_amdgcn_fence(__ATOMIC_ACQUIRE, "wavefront"); }
__device__ __forceinline__ float rdlane(float v, int l) { return __int_as_float(__builtin_amdgcn_readlane(__float_as_int(v), l)); }
__device__ __forceinline__ void unpack8(const u32x4 v, float* o) { o[0] = lo16(v.x); o[1] = hi16(v.x); o[2] = lo16(v.y); o[3] = hi16(v.y); o[4] = lo16(v.z); o[5] = hi16(v.z); o[6] = lo16(v.w); o[7] = hi16(v.w); }
__device__ __forceinline__ int mod_index(int m) { return m < M_LAT ? (m >> 12) : 8; }

namespace pg8 {
constexpr int BM = 256, BK = 64, HALF = 128, HTB = HALF * BK * 2, STAGE_BYTES = 8 * HTB, NXCD = 8, WGM = 8;
__host__ __device__ __forceinline__ int lds_byte(int r, int c) { const int st = (r >> 4) * 2 + (c >> 5), rr = r & 15, cc = c & 31, ob = rr * 64 + cc * 2; return st * 1024 + (ob ^ (((ob >> 9) & 1) << 5)); }
__host__ __device__ __forceinline__ void stage_rc(int b, int& R, int& C) { const int st = b / 1024, sb = b % 1024, swz = sb ^ (((sb >> 9) & 1) << 5); R = (st >> 1) * 16 + swz / 64; C = (st & 1) * 32 + (swz % 64) / 2; }
__host__ __device__ __forceinline__ int perm32(int rho) { const int n = rho >> 4, i = rho & 15; return 8 * (i >> 2) + 4 * n + (i & 3); }
struct Unit { int pm, pn; };
struct Gemm { const bf16_t* A; const bf16_t* Bt; int lda, ldb, K; int agrp, acol; };
struct StaticOrder {
    int nM, nN, nwg, G, c, rev;
    __device__ void init(int nM_, int nN_, int G_, int c_, int rev_ = 0) { nM = nM_; nN = nN_; nwg = nM * nN; G = G_; c = c_; rev = rev_; }
    __device__ bool next(int i, Unit& u) const {
        const long L = (long)i * G + c; if (L >= nwg) return false;
        int wgid = (int)L; { const int q = nwg / NXCD, r = nwg % NXCD, xcd = wgid % NXCD, off = wgid / NXCD; wgid = (xcd < r ? xcd * (q + 1) : r * (q + 1) + (xcd - r) * q) + off; }
        const int nig = WGM * nN, gid = wgid / nig, fm = gid * WGM, gsz = (nM - fm) < WGM ? (nM - fm) : WGM;
        u.pm = fm + ((wgid % nig) % gsz); u.pn = (wgid % nig) / gsz; if (rev) u.pm = nM - 1 - u.pm; return true;
    }
};
__device__ __forceinline__ unsigned cvt_pk_bf16(float lo, float hi) { unsigned r; asm volatile("v_cvt_pk_bf16_f32 %0, %1, %2" : "=v"(r) : "v"(lo), "v"(hi)); return r; }
__device__ __forceinline__ unsigned cvt_pk_bf16_t(float lo, float hi) { unsigned r; asm volatile("s_nop 1\n\tv_cvt_pk_bf16_f32 %0, %1, %2" : "=v"(r) : "v"(lo), "v"(hi)); return r; }

__device__ __forceinline__ unsigned ror8(unsigned v) { return (unsigned)__builtin_amdgcn_update_dpp(0, (int)v, 0x128, 0xF, 0xF, false); }
__device__ __forceinline__ void line_pair(const u32x4& x0, const u32x4& x1, bool hi, u32x4& a, u32x4& b) {
#pragma unroll
    for (int d = 0; d < 4; ++d) { const unsigned t = ror8(hi ? x0[d] : x1[d]); a[d] = hi ? t : x0[d]; b[d] = hi ? x1[d] : t; }
}
template <int PM> struct EpiBf16T;
template <> struct EpiBf16T<1> {
    static constexpr int PERM = 1;
    bf16_t* O; int ldc;
    __device__ __forceinline__ void operator()(const f32x4 (&acc)[2][2][4][2], const Unit& u, int wr, int wc, int fr, int fq) const {
        const int row0 = u.pm * BM + wr * 64 + fr; const int col0 = u.pn * BM + wc * 32 + 8 * fq;
#pragma unroll
        for (int ai = 0; ai < 2; ++ai)
#pragma unroll
            for (int m = 0; m < 4; ++m) { bf16_t* rowp = O + (size_t)(row0 + ai * HALF + m * 16) * ldc + col0;
#pragma unroll
                for (int bj = 0; bj < 2; ++bj) { const f32x4 v0 = acc[ai][bj][m][0], v1 = acc[ai][bj][m][1];
                    u32x4 w; w.x = cvt_pk_bf16(v0[0], v0[1]); w.y = cvt_pk_bf16(v0[2], v0[3]); w.z = cvt_pk_bf16(v1[0], v1[1]); w.w = cvt_pk_bf16(v1[2], v1[3]);
                    *(u32x4*)(rowp + bj * HALF) = w; } }
    }
};
template <> struct EpiBf16T<2> {
    static constexpr int PERM = 2;
    bf16_t* O; int ldc;
    __device__ __forceinline__ void operator()(const f32x4 (&acc)[2][2][4][2], const Unit& u, int wr, int wc, int fr, int fq) const {
        const bool hi = (fr >> 3) != 0;
        const int row0 = u.pm * BM + wr * 64 + (fr & 7); const int col0 = u.pn * BM + wc * 64 + ((fr >> 3) * 4 + fq) * 8;
#pragma unroll
        for (int ai = 0; ai < 2; ++ai)
#pragma unroll
            for (int m = 0; m < 4; ++m) { bf16_t* rowp = O + (size_t)(row0 + ai * HALF + m * 16) * ldc + col0;
                u32x4 x[2];
#pragma unroll
                for (int bj = 0; bj < 2; ++bj) { const f32x4 v0 = acc[ai][bj][m][0], v1 = acc[ai][bj][m][1];
                    x[bj].x = cvt_pk_bf16(v0[0], v0[1]); x[bj].y = cvt_pk_bf16(v0[2], v0[3]); x[bj].z = cvt_pk_bf16(v1[0], v1[1]); x[bj].w = cvt_pk_bf16(v1[2], v1[3]); }
                u32x4 a, b; line_pair(x[0], x[1], hi, a, b);
                *(u32x4*)rowp = a; *(u32x4*)(rowp + (size_t)8 * ldc) = b; }
    }
};
typedef _Float16 h16x2 __attribute__((ext_vector_type(2)));
__device__ __forceinline__ unsigned pk_f16(float a, float b) { h16x2 h; h.x = (_Float16)a; h.y = (_Float16)b; return __builtin_bit_cast(unsigned, h); }
struct EpiF16 {
    static constexpr int PERM = 2;
    unsigned short* O; int ldc;
    __device__ __forceinline__ void operator()(const f32x4 (&acc)[2][2][4][2], const Unit& u, int wr, int wc, int fr, int fq) const {
        const bool hi = (fr >> 3) != 0;
        const int row0 = u.pm * BM + wr * 64 + (fr & 7); const int col0 = u.pn * BM + wc * 64 + ((fr >> 3) * 4 + fq) * 8;
#pragma unroll
        for (int ai = 0; ai < 2; ++ai)
#pragma unroll
            for (int m = 0; m < 4; ++m) { unsigned short* rowp = O + (size_t)(row0 + ai * HALF + m * 16) * ldc + col0;
                u32x4 x[2];
#pragma unroll
                for (int bj = 0; bj < 2; ++bj) { const f32x4 v0 = acc[ai][bj][m][0], v1 = acc[ai][bj][m][1];
                    x[bj].x = pk_f16(v0[0], v0[1]); x[bj].y = pk_f16(v0[2], v0[3]); x[bj].z = pk_f16(v1[0], v1[1]); x[bj].w = pk_f16(v1[2], v1[3]); }
                u32x4 a, b; line_pair(x[0], x[1], hi, a, b);
                *(u32x4*)rowp = a; *(u32x4*)(rowp + (size_t)8 * ldc) = b; }
    }
};
struct EpiMerge {
    static constexpr int PERM = 0;
    const bf16_t* P; bf16_t* O;
    __device__ __forceinline__ void operator()(const f32x4 (&acc)[2][2][4][2], const Unit& u, int wr, int wc, int fr, int fq) const {
        const int row0 = u.pm * BM + wr * 64 + fr; const int oc = u.pn * 64 + wc * 16 + 4 * fq;
#pragma unroll
        for (int ai = 0; ai < 2; ++ai) {
            u32x2 pv[4][4];
#pragma unroll
            for (int m = 0; m < 4; ++m) { const size_t row = (size_t)(row0 + ai * HALF + m * 16);
#pragma unroll
                for (int br = 0; br < 4; ++br) pv[m][br] = *(const u32x2*)(P + row * 4096 + br * 1024 + oc); }
#pragma unroll
            for (int m = 0; m < 4; ++m) { const size_t row = (size_t)(row0 + ai * HALF + m * 16);
                f32x4 s = (f32x4){0.f, 0.f, 0.f, 0.f};
#pragma unroll
                for (int bj = 0; bj < 2; ++bj)
#pragma unroll
                    for (int n = 0; n < 2; ++n) { const int br = 2 * bj + n; const u32x2 p2 = pv[m][br]; const f32x4 g = acc[ai][bj][m][n];
                        s[0] += __builtin_amdgcn_rcpf(1.f + __expf(-g[0])) * __uint_as_float(p2.x << 16); s[1] += __builtin_amdgcn_rcpf(1.f + __expf(-g[1])) * __uint_as_float(p2.x & 0xffff0000u);
                        s[2] += __builtin_amdgcn_rcpf(1.f + __expf(-g[2])) * __uint_as_float(p2.y << 16); s[3] += __builtin_amdgcn_rcpf(1.f + __expf(-g[3])) * __uint_as_float(p2.y & 0xffff0000u); }
                u32x2 w; w.x = cvt_pk_bf16(s[0], s[1]); w.y = cvt_pk_bf16(s[2], s[3]);
                *(u32x2*)(O + row * 1024 + oc) = w; } }
    }
};

template <class Epi, bool ALIGN_EPI>
__device__ __forceinline__ void gemm_phase(LAS unsigned char* lds, const int tid, const Gemm g, const StaticOrder& S, const Epi& E) {
    const int wid = __builtin_amdgcn_readfirstlane(tid >> 6), lane = tid & 63, wr = wid >> 2, wc = wid & 3, fr = lane & 15, fq = lane >> 4;
    const int K = g.K, nt = K / BK;
    unsigned voffA[2], voffB[2];
#pragma unroll
    for (int i = 0; i < 2; ++i) { int R, C; stage_rc(tid * 16 + i * 8192, R, C); const int Rb = Epi::PERM == 2 ? (64 * (R >> 5) + perm32(R & 31)) : Epi::PERM == 1 ? ((R & ~31) + perm32(R & 31)) : R;
        voffA[i] = (unsigned)(R * g.lda + C) * 2u; voffB[i] = (unsigned)(Rb * g.ldb + C) * 2u; }
    const size_t kstep = (size_t)(BK * 2);
    const size_t hstepA = (size_t)HALF * g.lda * 2, hstepB = (size_t)(Epi::PERM == 2 ? 32 : HALF) * g.ldb * 2;
    const size_t tstepA = 2 * hstepA, tstepB = (size_t)BM * g.ldb * 2;
    const unsigned ldsw = (unsigned)wid * 1024u;
    const int aoff = lds_byte(wr * 64 + fr, fq * 8), boff = lds_byte(wc * 32 + fr, fq * 8);
#define PG8_SA(b, h) (((b) * 2 + (h)) * HTB)
#define PG8_SB(b, h) ((4 + (b) * 2 + (h)) * HTB)
#define PG8_STAGE(bufoff, gbase, voff) do { const char* _gb = (const char*)(gbase); asm volatile("" : "+s"(_gb));   \
        _Pragma("unroll") for (int _i = 0; _i < 2; ++_i) \
        __builtin_amdgcn_global_load_lds((const unsigned*)(_gb + (voff)[_i]), (LAS unsigned*)(lds + (bufoff) + ldsw + _i * 8192), 16, 0, 0); } while (0)
#define PG8_LDA(dst, b, h) do { _Pragma("unroll") for (int m = 0; m < 4; ++m) _Pragma("unroll") for (int k = 0; k < 2; ++k) dst[m][k] = *(const LAS bf16x8*)(lds + PG8_SA(b, h) + aoff + m * 2048 + k * 1024); } while (0)
#define PG8_LDB(dst, b, h) do { _Pragma("unroll") for (int n = 0; n < 2; ++n) _Pragma("unroll") for (int k = 0; k < 2; ++k) dst[n][k] = *(const LAS bf16x8*)(lds + PG8_SB(b, h) + boff + n * 2048 + k * 1024); } while (0)
#define PG8_MMA(ai, bj, At, Bt) do { __builtin_amdgcn_s_setprio(1); _Pragma("unroll") for (int m = 0; m < 4; ++m) _Pragma("unroll") for (int n = 0; n < 2; ++n) _Pragma("unroll") for (int k = 0; k < 2; ++k) \
        acc[ai][bj][m][n] = __builtin_amdgcn_mfma_f32_16x16x32_bf16(Bt[n][k], At[m][k], acc[ai][bj][m][n], 0, 0, 0); __builtin_amdgcn_s_setprio(0); } while (0)
#define PG8_WAIT_V(n) asm volatile("s_waitcnt vmcnt(" #n ")" ::: "memory")
#define PG8_WAIT_L(n) asm volatile("s_waitcnt lgkmcnt(" #n ")" ::: "memory")
#define PG8_BAR __builtin_amdgcn_s_barrier()
#define PG8_SCHED __builtin_amdgcn_sched_barrier(0)
#define PG8_UA(u) ((const char*)g.A + (size_t)(u).pm * tstepA + (size_t)(((u).pn / g.agrp) * g.acol) * 2)
#define PG8_UB(u) ((const char*)g.Bt + (size_t)(u).pn * tstepB)
    Unit cur, nxt; int ui = 0;
    if (!S.next(0, cur)) return;
    f32x4 acc[2][2][4][2];
#pragma unroll
    for (int a = 0; a < 2; ++a)
#pragma unroll
        for (int b = 0; b < 2; ++b)
#pragma unroll
            for (int m = 0; m < 4; ++m)
#pragma unroll
                for (int n = 0; n < 2; ++n) acc[a][b][m][n] = (f32x4){0.f, 0.f, 0.f, 0.f};
    bf16x8 At[4][2], B0[2][2], B1[2][2];
    const char* cA = PG8_UA(cur); const char* cB = PG8_UB(cur);
    PG8_STAGE(PG8_SB(0, 0), cB, voffB); PG8_STAGE(PG8_SB(0, 1), cB + hstepB, voffB); PG8_STAGE(PG8_SA(0, 0), cA, voffA); PG8_STAGE(PG8_SA(0, 1), cA + hstepA, voffA);
    if (wr == 1) PG8_BAR;
    PG8_WAIT_V(2); PG8_BAR;
    PG8_STAGE(PG8_SB(1, 0), cB + kstep, voffB); PG8_STAGE(PG8_SA(1, 0), cA + kstep, voffA); PG8_STAGE(PG8_SB(1, 1), cB + hstepB + kstep, voffB);
    PG8_WAIT_V(6); PG8_BAR;
    for (;;) {
        const bool has_next = S.next(ui + 1, nxt);
        const char* nA = has_next ? PG8_UA(nxt) : cA; const char* nB = has_next ? PG8_UB(nxt) : cB;
#pragma unroll 1
        for (int t = 0; t < nt; t += 2) {
            const bool last = (t == nt - 2);
            const char* a1 = cA + (size_t)(t + 1) * kstep;
            const char* a2 = last ? nA : cA + (size_t)(t + 2) * kstep; const char* b2 = last ? nB : cB + (size_t)(t + 2) * kstep;
            const char* a3 = a2 + kstep; const char* b3 = b2 + kstep;
            PG8_LDB(B0, 0, 0); PG8_LDB(B1, 0, 1); PG8_SCHED; PG8_LDA(At, 0, 0); PG8_STAGE(PG8_SA(1, 1), a1 + hstepA, voffA);
            PG8_WAIT_V(8); PG8_WAIT_L(0); PG8_BAR; PG8_MMA(0, 0, At, B0); PG8_MMA(0, 1, At, B1); PG8_BAR; PG8_SCHED;
            PG8_LDA(At, 0, 1); PG8_STAGE(PG8_SB(0, 0), b2, voffB); PG8_STAGE(PG8_SB(0, 1), b2 + hstepB, voffB); PG8_STAGE(PG8_SA(0, 0), a2, voffA);
            PG8_WAIT_V(8); PG8_WAIT_L(0); PG8_BAR; PG8_MMA(1, 0, At, B0); PG8_MMA(1, 1, At, B1); PG8_BAR; PG8_SCHED;
            PG8_LDB(B0, 1, 0); PG8_LDB(B1, 1, 1); PG8_SCHED; PG8_LDA(At, 1, 0); PG8_STAGE(PG8_SA(0, 1), a2 + hstepA, voffA);
            PG8_WAIT_V(8); PG8_WAIT_L(0); PG8_BAR; PG8_MMA(0, 0, At, B0); PG8_MMA(0, 1, At, B1); PG8_BAR; PG8_SCHED;
            PG8_LDA(At, 1, 1); PG8_STAGE(PG8_SB(1, 0), b3, voffB); PG8_STAGE(PG8_SB(1, 1), b3 + hstepB, voffB); PG8_STAGE(PG8_SA(1, 0), a3, voffA);
            PG8_WAIT_V(8); PG8_WAIT_L(0); PG8_BAR; PG8_MMA(1, 0, At, B0); PG8_MMA(1, 1, At, B1); PG8_BAR; PG8_SCHED;
        }
        if constexpr (ALIGN_EPI) { if (wr == 0) PG8_BAR; }
        E(acc, cur, wr, wc, fr, fq);
        if (!has_next) break;
#pragma unroll
        for (int a = 0; a < 2; ++a)
#pragma unroll
            for (int b = 0; b < 2; ++b)
#pragma unroll
                for (int m = 0; m < 4; ++m)
#pragma unroll
                    for (int n = 0; n < 2; ++n) acc[a][b][m][n] = (f32x4){0.f, 0.f, 0.f, 0.f};
        cur = nxt; cA = nA; cB = nB; ++ui;
        if constexpr (ALIGN_EPI) { if (wr == 1) PG8_BAR; }
    }
    PG8_WAIT_V(0);
    if constexpr (!ALIGN_EPI) { if (wr == 0) PG8_BAR; }
    PG8_BAR;
#undef PG8_SA
#undef PG8_SB
#undef PG8_STAGE
#undef PG8_LDA
#undef PG8_LDB
#undef PG8_MMA
#undef PG8_WAIT_V
#undef PG8_WAIT_L
#undef PG8_BAR
#undef PG8_SCHED
#undef PG8_UA
#undef PG8_UB
}
struct FusedArgs { const bf16_t* H; const bf16_t* WG; const bf16_t* Y; const bf16_t* WB; bf16_t* O; };
__device__ __forceinline__ void gemm_gates_fused(LAS unsigned char* lds, const int tid, const FusedArgs g, const StaticOrder& S) {
    const int wid = __builtin_amdgcn_readfirstlane(tid >> 6), lane = tid & 63, wr = wid >> 2, wc = wid & 3, fr = lane & 15, fq = lane >> 4;
    unsigned voffA[2];
#pragma unroll
    for (int i = 0; i < 2; ++i) { int R, C; stage_rc(tid * 16 + i * 8192, R, C); voffA[i] = (unsigned)(R * 1024 + C) * 2u; }
    const size_t kstep = (size_t)(BK * 2);
    const size_t hstepA = (size_t)HALF * 1024 * 2, hstepB = hstepA, tstep = 2 * hstepA;
    const unsigned ldsw = (unsigned)wid * 1024u;
    const unsigned ldsp = (unsigned)(((wid >> 1) * 4 + (wid & 1)) * 1024);
    const int aoff = lds_byte(wr * 64 + fr, fq * 8), boff = lds_byte(wc * 32 + fr, fq * 8);
#define PG8_SA(b, h) (((b) * 2 + (h)) * HTB)
#define PG8_SB(b, h) ((4 + (b) * 2 + (h)) * HTB)
#define PG8_STAGE(bufoff, gbase, voff) do { const char* _gb = (const char*)(gbase); asm volatile("" : "+s"(_gb));   \
        _Pragma("unroll") for (int _i = 0; _i < 2; ++_i) \
        __builtin_amdgcn_global_load_lds((const unsigned*)(_gb + (voff)[_i]), (LAS unsigned*)(lds + (bufoff) + ldsw + _i * 8192), 16, 0, 0); } while (0)
#define PG8_LDA(dst, b, h) do { _Pragma("unroll") for (int m = 0; m < 4; ++m) _Pragma("unroll") for (int k = 0; k < 2; ++k) dst[m][k] = *(const LAS bf16x8*)(lds + PG8_SA(b, h) + aoff + m * 2048 + k * 1024); } while (0)
#define PG8_LDB(dst, b, h) do { _Pragma("unroll") for (int n = 0; n < 2; ++n) _Pragma("unroll") for (int k = 0; k < 2; ++k) dst[n][k] = *(const LAS bf16x8*)(lds + PG8_SB(b, h) + boff + n * 2048 + k * 1024); } while (0)
#define PG8_MMA(ai, bj, At, Bt) do { __builtin_amdgcn_s_setprio(1); _Pragma("unroll") for (int m = 0; m < 4; ++m) _Pragma("unroll") for (int n = 0; n < 2; ++n) _Pragma("unroll") for (int k = 0; k < 2; ++k) \
        acc[ai][bj][m][n] = __builtin_amdgcn_mfma_f32_16x16x32_bf16(Bt[n][k], At[m][k], acc[ai][bj][m][n], 0, 0, 0); __builtin_amdgcn_s_setprio(0); } while (0)
#define PG8_WAIT_V(n) asm volatile("s_waitcnt vmcnt(" #n ")" ::: "memory")
#define PG8_WAIT_L(n) asm volatile("s_waitcnt lgkmcnt(" #n ")" ::: "memory")
#define PG8_BAR __builtin_amdgcn_s_barrier()
#define PG8_SCHED __builtin_amdgcn_sched_barrier(0)
#define F_LDB_G(b, bj, n) do { PG8_LDB(B0, b, 0); PG8_LDB(B1, b, 1); } while (0)
#define F_LDB_P(b, bj, n) do { _Pragma("unroll") for (int k = 0; k < 2; ++k) Bp[k] = *(const LAS bf16x8*)(lds + PG8_SB(b, bj) + boff + (n) * 2048 + k * 1024); } while (0)
#define F_MMA_G(ai) do { PG8_MMA(ai, 0, At, B0); PG8_MMA(ai, 1, At, B1); } while (0)
#define F_MMA_P(ai) do { __builtin_amdgcn_s_setprio(1); _Pragma("unroll") for (int k = 0; k < 2; ++k) _Pragma("unroll") for (int m = 0; m < 4; ++m) \
        pacc[ai][m] = __builtin_amdgcn_mfma_f32_16x16x32_bf16(Bp[k], At[m][k], pacc[ai][m], 0, 0, 0); __builtin_amdgcn_s_setprio(0); } while (0)
#define F_STB_G(b, bj, n, bptr) do { PG8_STAGE(PG8_SB(b, 0), bptr, vo); PG8_STAGE(PG8_SB(b, 1), (bptr) + hstepB, vo); } while (0)
#define F_STB_P(b, bj, n, bptr) do { const char* _gb = (const char*)(bptr); asm volatile("" : "+s"(_gb)); __builtin_amdgcn_global_load_lds((const unsigned*)(_gb + vp), (LAS unsigned*)(lds + PG8_SB(b, bj) + ldsp + (n) * 2048), 16, 0, 0); } while (0)
#define F_TRIP_BODY(LDB0, MMA0, bj0, n0, LDB1, MMA1, bj1, n1, A1, STB2, bj2, n2, B2, A2, STB3, bj3, n3, B3, A3, W1, W2, W3, W4) \
        LDB0(0, bj0, n0); PG8_SCHED; PG8_LDA(At, 0, 0); PG8_STAGE(PG8_SA(1, 1), (A1) + hstepA, vo); \
        PG8_WAIT_V(W1); PG8_WAIT_L(0); PG8_BAR; MMA0(0); PG8_BAR; PG8_SCHED; \
        PG8_LDA(At, 0, 1); STB2(0, bj2, n2, B2); PG8_STAGE(PG8_SA(0, 0), A2, vo); \
        PG8_WAIT_V(W2); PG8_WAIT_L(0); PG8_BAR; MMA0(1); PG8_BAR; PG8_SCHED; \
        LDB1(1, bj1, n1); PG8_SCHED; PG8_LDA(At, 1, 0); PG8_STAGE(PG8_SA(0, 1), (A2) + hstepA, vo); \
        PG8_WAIT_V(W3); PG8_WAIT_L(0); PG8_BAR; MMA1(0); PG8_BAR; PG8_SCHED; \
        PG8_LDA(At, 1, 1); STB3(1, bj3, n3, B3); PG8_STAGE(PG8_SA(1, 0), A3, vo); \
        PG8_WAIT_V(W4); PG8_WAIT_L(0); PG8_BAR; MMA1(1); PG8_BAR; PG8_SCHED;
#define F_TRIP(...) do { unsigned vo[2] = {voffA[0], voffA[1]}, vp = voffP; asm volatile("" : "+v"(vo[0]), "+v"(vo[1]), "+v"(vp));   \
        F_TRIP_BODY(__VA_ARGS__) } while (0)
#define F_TRIP_7(...) do { const unsigned vo[2] = {voffA[0], voffA[1]}; const unsigned vp = voffP; F_TRIP_BODY(__VA_ARGS__) } while (0)
#define F_TRIP_G(...) do { const unsigned vo[2] = {voffA[0], voffA[1]}; const unsigned vp = 0; (void)vp; F_TRIP_BODY(__VA_ARGS__) } while (0)
#define F_LDA_X(dst, b, h) do { _Pragma("unroll") for (int m = 0; m < 4; ++m) _Pragma("unroll") for (int k = 0; k < 2; ++k) dst[m][k] = *(const LAS bf16x8*)(lds + PG8_SA(b, h) + aoffP + m * 2048 + k * 1024); } while (0)
#define F_LDB_X(dst, b, bj, n) do { _Pragma("unroll") for (int k = 0; k < 2; ++k) dst[k] = *(const LAS bf16x8*)(lds + PG8_SB(b, bj) + boffP + (n) * 2048 + k * 1024); } while (0)
#define F_MMA_X(ai, Af, Bf) do { __builtin_amdgcn_s_setprio(1); _Pragma("unroll") for (int k = 0; k < 2; ++k) _Pragma("unroll") for (int m = 0; m < 4; ++m) \
        pacc[ai][m] = __builtin_amdgcn_mfma_f32_16x16x32_bf16(Bf[k], Af[m][k], pacc[ai][m], 0, 0, 0); __builtin_amdgcn_s_setprio(0); } while (0)
#define F_TRIP_P(bj, n, A1, STB2, bj2, n2, B2, A2, STB3, bj3, n3, B3, A3, W1, W2, W3, W4, H1, H2, H3, H4) do { \
        unsigned vo[2] = {voffA[0], voffA[1]}, vp = voffP; asm volatile("" : "+v"(vo[0]), "+v"(vo[1]), "+v"(vp)); \
        F_LDB_X(Bq0, 0, bj, n); PG8_SCHED; F_LDA_X(Aq0, 0, 0); PG8_STAGE(PG8_SA(1, 1), (A1) + hstepA, vo); H1; \
        PG8_WAIT_V(W1); PG8_WAIT_L(0); PG8_BAR; F_MMA_X(0, Aq0, Bq0); PG8_BAR; PG8_SCHED; \
        F_LDA_X(Aq0, 0, 1); STB2(0, bj2, n2, B2); PG8_STAGE(PG8_SA(0, 0), A2, vo); H2; \
        PG8_WAIT_V(W2); PG8_WAIT_L(0); PG8_BAR; F_MMA_X(1, Aq0, Bq0); PG8_BAR; PG8_SCHED; \
        F_LDB_X(Bq0, 1, bj, n); PG8_SCHED; F_LDA_X(Aq0, 1, 0); PG8_STAGE(PG8_SA(0, 1), (A2) + hstepA, vo); H3; \
        PG8_WAIT_V(W3); PG8_WAIT_L(0); PG8_BAR; F_MMA_X(0, Aq0, Bq0); PG8_BAR; PG8_SCHED; \
        F_LDA_X(Aq0, 1, 1); STB3(1, bj3, n3, B3); PG8_STAGE(PG8_SA(1, 0), A3, vo); H4; \
        PG8_WAIT_V(W4); PG8_WAIT_L(0); PG8_BAR; F_MMA_X(1, Aq0, Bq0); PG8_BAR; PG8_SCHED; } while (0)
#define F_SIG(h) do { _Pragma("unroll") for (int m = 0; m < 4; ++m) { const f32x4 gv = acc[(h) & 1][(h) >> 2][m][((h) >> 1) & 1]; unsigned pk = 0u; \
            pk = __builtin_amdgcn_cvt_pk_u8_f32(255.f * __builtin_amdgcn_rcpf(1.f + __expf(-gv[0])), 0, pk); pk = __builtin_amdgcn_cvt_pk_u8_f32(255.f * __builtin_amdgcn_rcpf(1.f + __expf(-gv[1])), 1, pk); \
            pk = __builtin_amdgcn_cvt_pk_u8_f32(255.f * __builtin_amdgcn_rcpf(1.f + __expf(-gv[2])), 2, pk); pk = __builtin_amdgcn_cvt_pk_u8_f32(255.f * __builtin_amdgcn_rcpf(1.f + __expf(-gv[3])), 3, pk); \
            sq[(h) >> 1][(h) & 1][m] = pk; } } while (0)
#define F_NOP() do { } while (0)
#define F_NEXT_P(bjx, nx) do { } while (0)
#define F_NEXT_NONE() do { } while (0)
#define F_UA(u) ((const char*)g.H + (size_t)(u).pm * tstep)
#define F_UB(u) ((const char*)g.WG + (size_t)(u).pn * tstep)
#define F_UY(u) ((const char*)g.Y + (size_t)(u).pm * tstep)
#define F_UW(u) ((const char*)g.WB + (size_t)(u).pn * (64 * 256 * 2))
#define F_PA(br, kt) (yA + (size_t)(((br) * 256 + (kt) * 64) * 2))
#define F_PB(br, kt) (wB + (size_t)((br) * 1024 * 256 + (kt) * 64) * 2)
#define F_ROT(ai, m) do { sq[0][ai][m] = sq[1][ai][m]; sq[1][ai][m] = sq[2][ai][m]; sq[2][ai][m] = sq[3][ai][m]; } while (0)
#define F_FOLD0() do { _Pragma("unroll") for (int ai = 0; ai < 2; ++ai) _Pragma("unroll") for (int m = 0; m < 4; ++m) { const unsigned sg = sq[0][ai][m]; \
            s[ai][m][0] = (float)(sg & 0xffu) * pacc[ai][m][0]; s[ai][m][1] = (float)((sg >> 8) & 0xffu) * pacc[ai][m][1]; \
            s[ai][m][2] = (float)((sg >> 16) & 0xffu) * pacc[ai][m][2]; s[ai][m][3] = (float)(sg >> 24) * pacc[ai][m][3]; \
            pacc[ai][m] = (f32x4){0.f, 0.f, 0.f, 0.f}; F_ROT(ai, m); } } while (0)
#define F_FOLD() do { _Pragma("unroll") for (int ai = 0; ai < 2; ++ai) _Pragma("unroll") for (int m = 0; m < 4; ++m) { const unsigned sg = sq[0][ai][m]; \
            s[ai][m][0] += (float)(sg & 0xffu) * pacc[ai][m][0]; s[ai][m][1] += (float)((sg >> 8) & 0xffu) * pacc[ai][m][1]; \
            s[ai][m][2] += (float)((sg >> 16) & 0xffu) * pacc[ai][m][2]; s[ai][m][3] += (float)(sg >> 24) * pacc[ai][m][3]; \
            pacc[ai][m] = (f32x4){0.f, 0.f, 0.f, 0.f}; F_ROT(ai, m); } } while (0)
    Unit cur, nxt; int ui = 0;
    if (!S.next(0, cur)) return;
    f32x4 acc[2][2][4][2];
#pragma unroll
    for (int a = 0; a < 2; ++a)
#pragma unroll
        for (int b = 0; b < 2; ++b)
#pragma unroll
            for (int m = 0; m < 4; ++m)
#pragma unroll
                for (int n = 0; n < 2; ++n) acc[a][b][m][n] = (f32x4){0.f, 0.f, 0.f, 0.f};
    bf16x8 At[4][2], B0[2][2], B1[2][2], Aq0[4][2], Bq0[2];
    const char* cA = F_UA(cur); const char* cB = F_UB(cur);
    PG8_STAGE(PG8_SB(0, 0), cB, voffA); PG8_STAGE(PG8_SB(0, 1), cB + hstepB, voffA); PG8_STAGE(PG8_SA(0, 0), cA, voffA); PG8_STAGE(PG8_SA(0, 1), cA + hstepA, voffA);
    if (wr == 1) PG8_BAR;
    PG8_WAIT_V(2); PG8_BAR;
    PG8_STAGE(PG8_SB(1, 0), cB + kstep, voffA); PG8_STAGE(PG8_SA(1, 0), cA + kstep, voffA); PG8_STAGE(PG8_SB(1, 1), cB + hstepB + kstep, voffA);
    PG8_WAIT_V(6); PG8_BAR;
    for (;;) {
        const bool has_next = S.next(ui + 1, nxt);
        const char* nA = has_next ? F_UA(nxt) : cA; const char* nB = has_next ? F_UB(nxt) : cB;
        const char* yA = F_UY(cur); const char* wB = F_UW(cur);
#pragma unroll 1
        for (int t = 0; t < 14; t += 2) {
            const char* a1 = cA + (size_t)(t + 1) * kstep; const char* a2 = cA + (size_t)(t + 2) * kstep; const char* b2 = cB + (size_t)(t + 2) * kstep;
            const char* a3 = a2 + kstep; const char* b3 = b2 + kstep;
            F_TRIP_G(F_LDB_G, F_MMA_G, 0, 0, F_LDB_G, F_MMA_G, 0, 0, a1, F_STB_G, 0, 0, b2, a2, F_STB_G, 0, 0, b3, a3, 8, 8, 8, 8);
        }
        unsigned voffP;
        { int ln = lane; asm volatile("" : "+v"(ln)); int R, C; stage_rc(((wid & 1) * 1024) + ln * 16, R, C); voffP = (unsigned)((16 * (wid >> 1) + (R & 15)) * 256 + C) * 2u; }
        F_TRIP_7(F_LDB_G, F_MMA_G, 0, 0, F_LDB_G, F_MMA_G, 0, 0, cA + (size_t)15 * kstep, F_STB_P, 0, 0, F_PB(0, 0), F_PA(0, 0), F_STB_P, 0, 0, F_PB(0, 1), F_PA(0, 1), 8, 5, 5, 5);
        unsigned sq[4][2][4];
        PG8_SCHED;
        int lnp = lane; asm volatile("" : "+v"(lnp));
        { int R, C; stage_rc(((wid & 1) * 1024) + lnp * 16, R, C); voffP = (unsigned)((16 * (wid >> 1) + (R & 15)) * 256 + C) * 2u; }
        const int frp = lnp & 15, fqp = lnp >> 4; const int aoffP = lds_byte(wr * 64 + frp, fqp * 8), boffP = lds_byte(wc * 32 + frp, fqp * 8);
        f32x4 pacc[2][4], s[2][4];
#pragma unroll
        for (int ai = 0; ai < 2; ++ai)
#pragma unroll
            for (int m = 0; m < 4; ++m) pacc[ai][m] = (f32x4){0.f, 0.f, 0.f, 0.f};
        F_TRIP_P(0, 0, F_PA(0, 1), F_STB_P, 0, 0, F_PB(0, 2), F_PA(0, 2), F_STB_P, 0, 0, F_PB(0, 3), F_PA(0, 3), 5, 5, 5, 5, F_SIG(0), F_SIG(1), F_SIG(2), F_SIG(3));
        F_TRIP_P(0, 0, F_PA(0, 3), F_STB_P, 0, 1, F_PB(1, 0), F_PA(1, 0), F_STB_P, 0, 1, F_PB(1, 1), F_PA(1, 1), 5, 5, 5, 5, F_SIG(4), F_SIG(5), F_SIG(6), F_SIG(7));
        F_FOLD0();
#pragma unroll 1
        for (int br = 1; br < 3; ++br) { const int bj = br >> 1, n = br & 1, brn = br + 1, bjn = brn >> 1, nn = brn & 1;
            F_TRIP_P(bj, n, F_PA(br, 1), F_STB_P, bj, n, F_PB(br, 2), F_PA(br, 2), F_STB_P, bj, n, F_PB(br, 3), F_PA(br, 3), 5, 5, 5, 5, F_NOP(), F_NOP(), F_NOP(), F_NOP());
            F_TRIP_P(bj, n, F_PA(br, 3), F_STB_P, bjn, nn, F_PB(brn, 0), F_PA(brn, 0), F_STB_P, bjn, nn, F_PB(brn, 1), F_PA(brn, 1), 5, 5, 5, 5, F_NOP(), F_NOP(), F_NOP(), F_NOP());
            F_FOLD(); }
        F_TRIP_P(1, 1, F_PA(3, 1), F_STB_P, 1, 1, F_PB(3, 2), F_PA(3, 2), F_STB_P, 1, 1, F_PB(3, 3), F_PA(3, 3), 5, 5, 5, 5, F_NOP(), F_NOP(), F_NOP(), F_NOP());
        F_TRIP_P(1, 1, F_PA(3, 3), F_STB_G, 0, 0, nB, nA, F_STB_G, 0, 0, nB + kstep, nA + kstep, 5, 8, 8, 8, F_NOP(), F_NOP(), F_NOP(), F_NOP());
        F_FOLD();
        if (wr == 0) PG8_BAR;
        { const int row0 = cur.pm * BM + wr * 64 + frp; const int oc = cur.pn * 64 + wc * 16 + 4 * fqp;
#pragma unroll
          for (int ai = 0; ai < 2; ++ai)
#pragma unroll
            for (int m = 0; m < 4; ++m) { const float q = 1.f / 255.f; u32x2 w; w.x = cvt_pk_bf16(q * s[ai][m][0], q * s[ai][m][1]); w.y = cvt_pk_bf16(q * s[ai][m][2], q * s[ai][m][3]);
                *(u32x2*)(g.O + (size_t)(row0 + ai * HALF + m * 16) * 1024 + oc) = w; } }
        if (!has_next) break;
#pragma unroll
        for (int a = 0; a < 2; ++a)
#pragma unroll
            for (int b = 0; b < 2; ++b)
#pragma unroll
                for (int m = 0; m < 4; ++m)
#pragma unroll
                    for (int n = 0; n < 2; ++n) acc[a][b][m][n] = (f32x4){0.f, 0.f, 0.f, 0.f};
        cur = nxt; cA = nA; cB = nB; ++ui;
        if (wr == 1) PG8_BAR;
    }
    PG8_WAIT_V(0);
    PG8_BAR;
#undef PG8_SA
#undef PG8_SB
#undef PG8_STAGE
#undef PG8_LDA
#undef PG8_LDB
#undef PG8_MMA
#undef PG8_WAIT_V
#undef PG8_WAIT_L
#undef PG8_BAR
#undef PG8_SCHED
}
}

struct Args { const float* in[29]; float* out; unsigned char* ws; int ph_lo, ph_hi; };

enum { I_X = 0, I_C, I_CTX, I_CCTX, I_ADAW, I_ADAB, I_WIN, I_RPB, I_GUP, I_GB, I_GNG, I_CDW, I_CB, I_CLG, I_CLB, I_SLG, I_SLB, I_SWS, I_SBS, I_WBR, I_WOUT, I_LN1G, I_LN1B, I_PWQ, I_PKEYS, I_PU, I_PV, I_LN2G, I_LN2B };

typedef const __attribute__((address_space(4))) Args* ArgsP;
struct Ctx {
    ArgsP a; LAS unsigned char* lds; unsigned char* ws;
    int tid, lane, wave, bid, nb;
};
#define WSP(T, off) ((T*)(C.ws + (off)))

__device__ __forceinline__ void phase_mod(const Ctx& C) {
    LAS float* cs = (LAS float*)C.lds;
    LAS float* red = cs + 9 * 1024;
    const float* c = C.a->in[I_C]; const float* cc = C.a->in[I_CCTX]; const float* adaw = C.a->in[I_ADAW]; const float* adab = C.a->in[I_ADAB];
    float* MOD = WSP(float, WS_MOD);
    bool loaded = false;
    for (int item = C.bid; item < 192; item += C.nb) {
        if (!loaded) { for (int i = C.tid; i < 9 * 1024; i += NT) { const int b = i >> 10, k = i & 1023; const float v = b < 8 ? c[b * 1024 + k] : cc[k]; cs[i] = siluf_(v); } __syncthreads(); loaded = true; }
        const int l = item / 96, cb = item % 96, cl = C.tid & 63, kg = C.tid >> 6;
        float acc[9];
#pragma unroll
        for (int b = 0; b < 9; ++b) acc[b] = 0.f;
        const float* w = adaw + (size_t)l * 1024 * 6144 + cb * 64 + cl;
        for (int k = kg * 128; k < kg * 128 + 128; ++k) { const float wv = w[(size_t)k * 6144];
#pragma unroll
            for (int b = 0; b < 9; ++b) acc[b] += cs[b * 1024 + k] * wv; }
#pragma unroll
        for (int b = 0; b < 9; ++b) red[(kg * 9 + b) * 64 + cl] = acc[b];
        __syncthreads();
        for (int i = C.tid; i < 576; i += NT) { const int b = i >> 6, q = i & 63; float s = 0.f;
#pragma unroll
            for (int g = 0; g < 8; ++g) s += red[(g * 9 + b) * 64 + q];
            MOD[(size_t)(l * 9 + b) * 6144 + cb * 64 + q] = s + adab[l * 6144 + cb * 64 + q]; }
        __syncthreads();
    }
}

__device__ __forceinline__ int src_col(int map, int n) {
    if (map == 0) return n;
    if (map == 1) return n < 2592 ? n : -1;
    const int pn = n >> 8, c = n & 255, bj = c >> 7, wc = (c >> 5) & 3, nn = (c >> 4) & 1, fq = (c >> 2) & 3, j = c & 3;
    return ZGATE + (2 * bj + nn) * 1024 + pn * 64 + wc * 16 + fq * 4 + j;
}
__device__ __forceinline__ void convert_item(const Ctx& C, bf16_t* dst, int K, const float* src, int ld, int map, int ir, int ik) {
    LAS float* tile = (LAS float*)C.lds;
    const int n0 = ir * 64, k0 = ik * 64;
    { const int nl = C.tid & 63, ks = C.tid >> 6; const int sc = src_col(map, n0 + nl);
#pragma unroll
      for (int it = 0; it < 8; ++it) { const int k = ks + 8 * it; tile[k * 65 + nl] = sc >= 0 ? src[(size_t)(k0 + k) * ld + sc] : 0.f; } }
    __syncthreads();
    { const int kg = C.tid & 7, n = C.tid >> 3;
      const LAS float* t8 = tile + (kg * 8) * 65 + n;
      u32x4 w; w.x = pk2(t8[0], t8[65]); w.y = pk2(t8[2 * 65], t8[3 * 65]); w.z = pk2(t8[4 * 65], t8[5 * 65]); w.w = pk2(t8[6 * 65], t8[7 * 65]);
      *(u32x4*)(dst + (size_t)(n0 + n) * K + k0 + kg * 8) = w; }
    __syncthreads();
}
__device__ __forceinline__ void phase_convert(const Ctx& C) {
    for (int item = C.bid; item < 2 * 2240; item += C.nb) {
        const int l = item / 2240; int r = item % 2240;
        unsigned char* wl = C.ws + WS_W + (size_t)l * W_LAYER;
        const float* win = C.a->in[I_WIN] + (size_t)l * 1024 * WIN_COLS;
        if (r < 704) { convert_item(C, (bf16_t*)(wl + W_WIN), 1024, win, WIN_COLS, 1, r / 16, r % 16); continue; } r -= 704;
        if (r < 1024) { convert_item(C, (bf16_t*)(wl + W_WG), 1024, win, WIN_COLS, 2, r / 16, r % 16); continue; } r -= 1024;
        if (r < 256) { const int i = r / 64, q = r % 64; convert_item(C, (bf16_t*)(wl + W_WB) + (size_t)i * 1024 * 256, 256, C.a->in[I_WBR] + (size_t)(l * 4 + i) * 256 * 1024, 1024, 0, q / 4, q % 4); continue; } r -= 256;
        convert_item(C, (bf16_t*)(wl + W_WO), 1024, C.a->in[I_WOUT] + (size_t)l * 1024 * 1024, 1024, 0, r / 16, r % 16);
    }
}
__device__ __forceinline__ void phase_fold(const Ctx& C) {
    LAS float* wqt = (LAS float*)C.lds;
    LAS float* kt = wqt + 64 * 128;
    for (int item = C.bid; item < 512; item += C.nb) {
        const int l = item >> 8, g = (item >> 4) & 15, kb = item & 15, k0 = kb * 64;
        const float* wq = C.a->in[I_PWQ] + (size_t)l * 1024 * 2048; const float* keys = C.a->in[I_PKEYS] + (size_t)(l * 16 + g) * 128 * 128;
        for (int i = C.tid; i < 64 * 128; i += NT) { const int kk = i >> 7, d = i & 127; wqt[i] = wq[(size_t)(k0 + kk) * 2048 + g * 128 + d]; }
        for (int i = C.tid; i < 128 * 128; i += NT) { const int j = i >> 7, d = i & 127; kt[j * 129 + d] = keys[i]; }
        __syncthreads();
        const int j = C.tid & 127, kq = C.tid >> 7;
        float acc[16];
#pragma unroll
        for (int i = 0; i < 16; ++i) acc[i] = 0.f;
        for (int d = 0; d < 128; ++d) { const float kv = kt[j * 129 + d];
#pragma unroll
            for (int i = 0; i < 16; ++i) acc[i] += wqt[(kq * 16 + i) * 128 + d] * kv; }
        bf16_t* dst = (bf16_t*)(C.ws + WS_W + (size_t)l * W_LAYER + W_WS) + (size_t)(g * 128 + j) * 1024 + k0 + kq * 16;
        u32x4 w0, w1; w0.x = pk2(acc[0], acc[1]); w0.y = pk2(acc[2], acc[3]); w0.z = pk2(acc[4], acc[5]); w0.w = pk2(acc[6], acc[7]);
        w1.x = pk2(acc[8], acc[9]); w1.y = pk2(acc[10], acc[11]); w1.z = pk2(acc[12], acc[13]); w1.w = pk2(acc[14], acc[15]);
        *(u32x4*)dst = w0; *(u32x4*)(dst + 8) = w1;
        __syncthreads();
    }
}
__device__ __forceinline__ void phase_h0(const Ctx& C) {
    const float* MOD = WSP(float, WS_MOD); bf16_t* H = WSP(bf16_t, WS_H);
    for (int m0 = (C.bid * 8 + C.wave) * 4; m0 < M_ALL; m0 += C.nb * 8 * 4) {
        f32x4 xv[4][4];
#pragma unroll
        for (int r = 0; r < 4; ++r) { const int m = m0 + r; const float* xr = m < M_LAT ? C.a->in[I_X] + (size_t)m * 1024 : C.a->in[I_CTX] + (size_t)(m - M_LAT) * 1024;
#pragma unroll
            for (int j = 0; j < 4; ++j) xv[r][j] = *(const f32x4*)(xr + 4 * C.lane + 256 * j); }
#pragma unroll
        for (int r = 0; r < 4; ++r) { const int m = m0 + r; const float* md = MOD + (size_t)(0 * 9 + mod_index(m)) * 6144;
#pragma unroll
            for (int j = 0; j < 4; ++j) { const int col = 4 * C.lane + 256 * j; const f32x4 sh = *(const f32x4*)(md + col), sc = *(const f32x4*)(md + 1024 + col);
                const f32x4 h = xv[r][j] * (sc + 1.f) + sh; u32x2 w; w.x = pk2(h[0], h[1]); w.y = pk2(h[2], h[3]); *(u32x2*)(H + (size_t)m * 1024 + col) = w; } }
    }
}

__device__ __forceinline__ void phase_g0(const Ctx& C, int l) {
    const bf16_t* Z = WSP(bf16_t, B_Z); float* AF = WSP(float, B_AF); float* AB = WSP(float, B_AB); bf16_t* QP = WSP(bf16_t, B_QP); bf16_t* KP = WSP(bf16_t, B_KP);
    const float* gup = C.a->in[I_GUP] + (size_t)l * 2 * 16 * 128; const float* gb = C.a->in[I_GB] + (size_t)l * 2 * 128;
    const long total = (long)M_ALL * 128;
    for (long idx = (long)C.bid * NT + C.tid; idx < total; idx += (long)C.nb * NT) {
        const int m = (int)(idx >> 7), col = (int)(idx & 127), d = col & 31;
        const bf16_t* zr = Z + (size_t)m * ZP;
        float lf = gb[col], lb = gb[128 + col];
#pragma unroll
        for (int r = 0; r < 16; ++r) { lf += bf2f(zr[ZLO + r]) * gup[r * 128 + col]; lb += bf2f(zr[ZLO + 16 + r]) * gup[(16 + r) * 128 + col]; }
        AF[idx] = (fminf(lf, 0.f) - log1pf(__expf(-fabsf(lf)))) * (1.f / 16.f);
        AB[idx] = (fminf(lb, 0.f) - log1pf(__expf(-fabsf(lb)))) * (1.f / 16.f);
        float q = bf2f(zr[ZGQ + col]) * 0.17677669529663687f, k = bf2f(zr[ZGK + col]);
        if (m < M_LAT) {
            const float qp = bf2f(zr[ZGQ + (col ^ 8)]) * 0.17677669529663687f, kp = bf2f(zr[ZGK + (col ^ 8)]);
            const int t = m & 4095, row = t >> 6, cl = t & 63; const int i = d & 7; const bool first = !(d & 8); const int pos = (d >> 4) ? cl : row;
            const float inv = __expf(-(float)i * (4.605170185988092f / 8.f));
            const float ang = (float)pos * inv; const float kk = rintf(ang * 0.15915494309189535f); const float rr = (ang - kk * 6.28125f) - kk * 1.9353071795864769e-3f; const float cs = __cosf(rr), sn = __sinf(rr);
            const float qn = first ? q * cs - qp * sn : qp * sn + q * cs; const float kn = first ? k * cs - kp * sn : kp * sn + k * cs;
            q = qn; k = kn;
        }
        QP[idx] = (bf16_t)f2bf(q); KP[idx] = (bf16_t)f2bf(k);
    }
}
__device__ __forceinline__ void phase_g1(const Ctx& C) {
    if (C.wave != 0 || C.bid >= 64) return;
    const int item = C.bid, b = item >> 3, h = (item >> 1) & 3, dir = item & 1, e = C.lane;
    const bf16_t* Z = WSP(bf16_t, B_Z); const float* LA = dir ? WSP(float, B_AB) : WSP(float, B_AF); const bf16_t* QP = WSP(bf16_t, B_QP); const bf16_t* KP = WSP(bf16_t, B_KP);
    bf16_t* O = dir ? WSP(bf16_t, B_OB) : WSP(bf16_t, B_OF);
    float s[32];
#pragma unroll
    for (int d = 0; d < 32; ++d) s[d] = 0.f;
    for (int step = 0; step < CTXL + SEQ; ++step) {
        int m;
        if (step < CTXL) { const int li = dir ? (CTXL - 1 - step) : step; m = M_LAT + b * CTXL + li; }
        else { int t = step - CTXL; if (dir) t = SEQ - 1 - t; m = b * SEQ + t; }
        const size_t o128 = (size_t)m * 128 + h * 32 + (e & 31);
        const float av = __expf(LA[o128]), kv = bf2f(KP[o128]), qv = bf2f(QP[o128]);
        const float v = bf2f(Z[(size_t)m * ZP + ZGV + h * 64 + e]);
        float o = 0.f;
#pragma unroll
        for (int d = 0; d < 32; ++d) { const float ad = rdlane(av, d), kd = rdlane(kv, d), qd = rdlane(qv, d); s[d] = ad * s[d] + kd * v; o += qd * s[d]; }
        O[(size_t)m * 256 + h * 64 + e] = (bf16_t)f2bf(o);
    }
}
__device__ __forceinline__ void phase_g2(const Ctx& C, int l) {
    const bf16_t* Z = WSP(bf16_t, B_Z); const bf16_t* OF = WSP(bf16_t, B_OF); const bf16_t* OB = WSP(bf16_t, B_OB); bf16_t* Y = WSP(bf16_t, WS_Y);
    const float* ng = C.a->in[I_GNG] + (size_t)l * 256;
    for (int m = C.bid * 8 + C.wave; m < M_ALL; m += C.nb * 8) {
        const int c0 = 4 * C.lane;
        const u32x2 a = *(const u32x2*)(OF + (size_t)m * 256 + c0), bq = *(const u32x2*)(OB + (size_t)m * 256 + c0), rr = *(const u32x2*)(Z + (size_t)m * ZP + ZGR + c0);
        float o[4] = {lo16(a.x) + lo16(bq.x), hi16(a.x) + hi16(bq.x), lo16(a.y) + lo16(bq.y), hi16(a.y) + hi16(bq.y)};
        float ss = o[0] * o[0] + o[1] * o[1] + o[2] * o[2] + o[3] * o[3];
        ss += __shfl_xor(ss, 1); ss += __shfl_xor(ss, 2); ss += __shfl_xor(ss, 4); ss += __shfl_xor(ss, 8);
        const float rs = rsqrtf(ss * (1.f / 64.f) + LN_EPS);
        const float r[4] = {lo16(rr.x), hi16(rr.x), lo16(rr.y), hi16(rr.y)};
        float y[4];
#pragma unroll
        for (int j = 0; j < 4; ++j) y[j] = o[j] * rs * ng[c0 + j] * siluf_(r[j]);
        u32x2 w; w.x = pk2(y[0], y[1]); w.y = pk2(y[2], y[3]); *(u32x2*)(Y + (size_t)m * 1024 + 256 + c0) = w;
    }
}

constexpr size_t B_U = B_OF;
constexpr size_t B_DEC = B_VN + 34 * MiB;

__device__ __forceinline__ float logsig16(float x) { return (fminf(x, 0.f) - log1pf(__expf(-fabsf(x)))) * (1.f / 16.f); }

template <bool NEED_Q>
__device__ __forceinline__ void gla_prep(const Ctx& C, int l, int cid, int h, int dir, float (&b)[32], float (&q)[32], float (&k)[32]) {
    const bf16_t* Z = WSP(bf16_t, B_Z);
    const int lane = C.lane; const bf16_t* zr = Z + (size_t)(cid * 64 + lane) * ZP;
    float lo[16];
    { const u32x4* lp = (const u32x4*)(zr + ZLO + dir * 16); float t[8]; unpack8(lp[0], t);
#pragma unroll
      for (int i = 0; i < 8; ++i) lo[i] = t[i];
      unpack8(lp[1], t);
#pragma unroll
      for (int i = 0; i < 8; ++i) lo[8 + i] = t[i]; }
    const float* gup = C.a->in[I_GUP] + (size_t)((l * 2 + dir) * 16) * 128 + h * 32; const float* gb = C.a->in[I_GB] + (size_t)(l * 2 + dir) * 128 + h * 32;
    float G[8];
#pragma unroll
    for (int kk = 0; kk < 8; ++kk) { const int f = kk * 64 + lane; G[kk] = gup[(f >> 5) * 128 + (f & 31)]; }
    const float GB = gb[lane & 31];
#pragma unroll
    for (int d = 0; d < 32; ++d) { float x = rdlane(GB, d);
#pragma unroll
        for (int r = 0; r < 16; ++r) { const int f = r * 32 + d; x += lo[r] * rdlane(G[f >> 6], f & 63); }
        b[d] = logsig16(x); }
    if (dir == 0) {
#pragma unroll
        for (int off = 1; off < 64; off <<= 1) {
#pragma unroll
            for (int d = 0; d < 32; ++d) { const float t = __shfl_up(b[d], off); if (lane >= off) b[d] += t; } }
    } else {
#pragma unroll
        for (int off = 1; off < 64; off <<= 1) {
#pragma unroll
            for (int d = 0; d < 32; ++d) { const float t = __shfl_down(b[d], off); if (lane + off < 64) b[d] += t; } }
    }
    { const u32x4* kp = (const u32x4*)(zr + ZGK + h * 32);
#pragma unroll
      for (int i = 0; i < 4; ++i) unpack8(kp[i], k + 8 * i); }
    if (NEED_Q) { const u32x4* qp = (const u32x4*)(zr + ZGQ + h * 32);
#pragma unroll
      for (int i = 0; i < 4; ++i) unpack8(qp[i], q + 8 * i);
#pragma unroll
      for (int d = 0; d < 32; ++d) q[d] *= 0.17677669529663687f; }
    if (cid < 512) {
        const int row = cid & 63;
#pragma unroll
        for (int hh = 0; hh < 2; ++hh) { const float pos = (float)(hh ? lane : row);
#pragma unroll
            for (int i = 0; i < 8; ++i) { const float inv = __expf(-(float)i * (4.605170185988092f / 8.f)); const float ang = pos * inv;
                const float kk = rintf(ang * 0.15915494309189535f); const float rr = (ang - kk * 6.28125f) - kk * 1.9353071795864769e-3f; const float cs = __cosf(rr), sn = __sinf(rr);
                const int d1 = hh * 16 + i, d2 = d1 + 8;
                { const float x1 = k[d1], x2 = k[d2]; k[d1] = x1 * cs - x2 * sn; k[d2] = x1 * sn + x2 * cs; }
                if (NEED_Q) { const float x1 = q[d1], x2 = q[d2]; q[d1] = x1 * cs - x2 * sn; q[d2] = x1 * sn + x2 * cs; } } }
    }
}
__device__ __forceinline__ void phase_gla_a(const Ctx& C, int l) {
    const bf16_t* Z = WSP(bf16_t, B_Z); float* U = WSP(float, B_U); float* DEC = WSP(float, B_DEC);
    const int nw = C.nb * 8;
    for (int item = C.wave * C.nb + C.bid; item < 544 * 8; item += nw) {
        const int cid = item >> 3, h = (item >> 1) & 3, dir = item & 1, lane = C.lane;
        float b[32], k[32], qd[32];
        gla_prep<false>(C, l, cid, h, dir, b, qd, k);
        float tot[32];
#pragma unroll
        for (int d = 0; d < 32; ++d) { tot[d] = rdlane(b[d], dir ? 0 : 63); k[d] *= __expf(tot[d] - b[d]); }
        float vv[64];
        { const bf16_t* vp = Z + (size_t)(cid * 64) * ZP + ZGV + h * 64; int ln = lane; asm volatile("" : "+v"(ln));
#pragma unroll
          for (int i = 0; i < 64; ++i) vv[i] = bf2f((vp + (size_t)i * ZP)[ln]); }
        float u[32];
#pragma unroll
        for (int d = 0; d < 32; ++d) u[d] = 0.f;
#pragma unroll
        for (int i = 0; i < 64; ++i) {
#pragma unroll
            for (int d = 0; d < 32; ++d) u[d] += rdlane(k[d], i) * vv[i]; }
        const size_t off = (size_t)((cid * 4 + h) * 2 + dir);
        { float* up = U + off * 2048; int ln = lane; asm volatile("" : "+v"(ln));
#pragma unroll
          for (int d = 0; d < 32; ++d) (up + d * 64)[ln] = u[d]; }
        if (lane < 32) { float dv = 0.f;
#pragma unroll
            for (int d = 0; d < 32; ++d) dv = (lane == d) ? tot[d] : dv;
            DEC[off * 32 + lane] = __expf(dv); }
    }
}
__device__ __forceinline__ void phase_gla_scan(const Ctx& C) {
    float* U = WSP(float, B_U); const float* DEC = WSP(float, B_DEC);
    for (int idx = C.bid * NT + C.tid; idx < 64 * 2048; idx += C.nb * NT) {
        const int chain = idx >> 11, de = idx & 2047, d = de >> 6, b = chain >> 3, h = (chain >> 1) & 3, dir = chain & 1;
        float s = 0.f;
        for (int st = 0; st < 68; st += 4) {
            size_t off[4]; float tmp[4], dc[4];
#pragma unroll
            for (int j = 0; j < 4; ++j) { const int step = st + j; int cid;
                if (step < 4) cid = 512 + b * 4 + (dir ? 3 - step : step); else { const int n = step - 4; cid = b * 64 + (dir ? 63 - n : n); }
                off[j] = (size_t)((cid * 4 + h) * 2 + dir); tmp[j] = U[off[j] * 2048 + de]; dc[j] = DEC[off[j] * 32 + d]; }
#pragma unroll
            for (int j = 0; j < 4; ++j) { U[off[j] * 2048 + de] = s; s = dc[j] * s + tmp[j]; }
        }
    }
}
__device__ __forceinline__ void phase_gla_out(const Ctx& C, int l) {
    const bf16_t* Z = WSP(bf16_t, B_Z); const float* U = WSP(float, B_U); bf16_t* Y = WSP(bf16_t, WS_Y);
    const float* ng = C.a->in[I_GNG] + (size_t)l * 256;
    LAS float* o = (LAS float*)(C.lds + C.wave * 16640);
    const int nitems = (l == 0 ? 544 : 512) * 4, nw = C.nb * 8, lane = C.lane;
    for (int item = C.wave * C.nb + C.bid; item < nitems; item += nw) {
        const int cid = item >> 2, h = item & 3;
#pragma unroll 1
        for (int dir = 0; dir < 2; ++dir) {
            float b[32], qs[32], ks[32];
            gla_prep<true>(C, l, cid, h, dir, b, qs, ks);
#pragma unroll
            for (int d = 0; d < 32; ++d) { const float eb = __expf(b[d]); qs[d] *= eb; ks[d] *= __expf(-b[d]); }
            asm volatile("" ::: "memory");
            float vv[64], S[32];
            { const bf16_t* vp = Z + (size_t)(cid * 64) * ZP + ZGV + h * 64; int ln = lane; asm volatile("" : "+v"(ln));
#pragma unroll
              for (int i = 0; i < 64; ++i) vv[i] = bf2f((vp + (size_t)i * ZP)[ln]);
              const float* sp = U + (size_t)((cid * 4 + h) * 2 + dir) * 2048;
#pragma unroll
              for (int d = 0; d < 32; ++d) S[d] = (sp + d * 64)[ln]; }
#pragma unroll 1
            for (int c = 0; c < 64; ++c) {
                float a = 0.f, oc = 0.f;
#pragma unroll
                for (int d = 0; d < 32; ++d) { const float qd = rdlane(qs[d], c); a += qd * ks[d]; oc += qd * S[d]; }
                const bool ok = dir ? (lane >= c) : (lane <= c);
                a = ok ? a : 0.f;
#pragma unroll
                for (int s2 = 0; s2 < 64; ++s2) oc += rdlane(a, s2) * vv[s2];
                if (dir == 0) o[c * 65 + lane] = oc; else o[c * 65 + lane] += oc;
            }
        }
        wave_sync();
        float ss = 0.f;
#pragma unroll 8
        for (int e = 0; e < 64; ++e) { const float t = o[lane * 65 + e]; ss += t * t; }
        const float rs = rsqrtf(ss * (1.f / 64.f) + LN_EPS);
        const float g = ng[h * 64 + lane];
#pragma unroll 4
        for (int c = 0; c < 64; ++c) { const size_t m = (size_t)(cid * 64 + c);
            const float r = bf2f(Z[m * ZP + ZGR + h * 64 + lane]);
            Y[m * 1024 + 256 + h * 64 + lane] = (bf16_t)f2bf(o[c * 65 + lane] * rdlane(rs, c) * g * siluf_(r)); }
        wave_sync();
    }
}


constexpr int NA_VSTR = 136, NA_VBUF = 256 * NA_VSTR, NA_RPB_OFF = 2 * NA_VBUF;
__device__ __forceinline__ void na_vload(const bf16_t* Z, int mk0, int wave, int lane, u32x4 (&vr)[4]) {
#pragma unroll
    for (int i = 0; i < 4; ++i) { const int gidx = wave * 4 + i, key = (gidx & 3) * 16 + (lane & 15), col8 = (gidx >> 2) * 4 + (lane >> 4);
        vr[i] = *(const u32x4*)(Z + (size_t)(mk0 + key) * ZP + ZV + col8 * 8); }
}
__device__ __forceinline__ void na_vstore(LAS unsigned char* vb, int wave, int lane, const u32x4 (&vr)[4]) {
#pragma unroll
    for (int i = 0; i < 4; ++i) { const int gidx = wave * 4 + i, key = (gidx & 3) * 16 + (lane & 15), col8 = (gidx >> 2) * 4 + (lane >> 4);
        LAS unsigned char* p = vb + (col8 * 8) * NA_VSTR + key * 2;
        *(LAS bf16_t*)(p + 0 * NA_VSTR) = (bf16_t)(vr[i].x & 0xffffu); *(LAS bf16_t*)(p + 1 * NA_VSTR) = (bf16_t)(vr[i].x >> 16);
        *(LAS bf16_t*)(p + 2 * NA_VSTR) = (bf16_t)(vr[i].y & 0xffffu); *(LAS bf16_t*)(p + 3 * NA_VSTR) = (bf16_t)(vr[i].y >> 16);
        *(LAS bf16_t*)(p + 4 * NA_VSTR) = (bf16_t)(vr[i].z & 0xffffu); *(LAS bf16_t*)(p + 5 * NA_VSTR) = (bf16_t)(vr[i].z >> 16);
        *(LAS bf16_t*)(p + 6 * NA_VSTR) = (bf16_t)(vr[i].w & 0xffffu); *(LAS bf16_t*)(p + 7 * NA_VSTR) = (bf16_t)(vr[i].w >> 16); }
}
__device__ __forceinline__ void phase_na2(const Ctx& C, int l) {
    const bf16_t* Z = WSP(bf16_t, B_Z); bf16_t* Y = WSP(bf16_t, WS_Y);
    const float* rpb = C.a->in[I_RPB] + (size_t)l * 4 * 15 * 31;
    LAS float* rpbL = (LAS float*)(C.lds + NA_RPB_OFF);
    const int lane = C.lane, wave = C.wave, h = wave >> 1, qh = wave & 1, fr = lane & 15, fq = lane >> 4;
    for (int i = C.tid; i < 4 * 15 * 31; i += NT) rpbL[i] = rpb[i];
    const int nunits = (l == 0) ? 544 : 512;
    for (int ui = C.bid; ui < nunits; ui += C.nb) {
        int unit = ui;
        if (C.nb == 256 && ui < 512) unit = (C.bid & 7) * 64 + (C.bid >> 3) + 32 * (ui >> 8);
        int b, r = 0, r0 = 0, nwin, mq0;
        if (unit < 512) { b = unit >> 6; r = unit & 63; r0 = min(max(r - 4, 0), 56); nwin = 8; mq0 = b * SEQ + r * 64; }
        else { const int uc = unit - 512; b = uc >> 2; nwin = 0; mq0 = M_LAT + b * CTXL + (uc & 3) * 64; }
        const int ntile = nwin + 4;
        bf16x8 qf[2][2];
#pragma unroll
        for (int qb = 0; qb < 2; ++qb)
#pragma unroll
            for (int ks = 0; ks < 2; ++ks) qf[qb][ks] = *(const bf16x8*)(Z + (size_t)(mq0 + 32 * qh + 16 * qb + fr) * ZP + ZQ + h * 64 + ks * 32 + fq * 8);
        int c0q[2];
#pragma unroll
        for (int qb = 0; qb < 2; ++qb) c0q[qb] = min(max(32 * qh + 16 * qb + fr - 8, 0), 48);
        f32x4 ot[4][2];
#pragma unroll
        for (int db = 0; db < 4; ++db)
#pragma unroll
            for (int qb = 0; qb < 2; ++qb) ot[db][qb] = (f32x4){0.f, 0.f, 0.f, 0.f};
        float mrun[2] = {-1e30f, -1e30f}, lrun[2] = {0.f, 0.f};
        __syncthreads();
        bf16x8 kf[4][2];
        { u32x4 vr[4]; const int mk0 = nwin ? (b * SEQ + r0 * 64) : (M_LAT + b * CTXL); na_vload(Z, mk0, wave, lane, vr);
#pragma unroll
          for (int kb = 0; kb < 4; ++kb)
#pragma unroll
              for (int ks = 0; ks < 2; ++ks) kf[kb][ks] = *(const bf16x8*)(Z + (size_t)(mk0 + 16 * kb + fr) * ZP + ZK + h * 64 + ks * 32 + fq * 8);
          na_vstore(C.lds, wave, lane, vr); }
        __syncthreads();
#pragma unroll 1
        for (int t = 0; t < ntile; ++t) {
            const bool win = t < nwin;
            u32x4 vr[4];
            const int t1 = t + 1; const int mk1 = (t1 < nwin) ? (b * SEQ + (r0 + t1) * 64) : (M_LAT + b * CTXL + (t1 - nwin) * 64);
            if (t1 < ntile) na_vload(Z, mk1, wave, lane, vr);
            f32x4 st[4][2];
#pragma unroll
            for (int kb = 0; kb < 4; ++kb)
#pragma unroll
                for (int qb = 0; qb < 2; ++qb) { f32x4 a = (f32x4){0.f, 0.f, 0.f, 0.f};
#pragma unroll
                    for (int ks = 0; ks < 2; ++ks) a = __builtin_amdgcn_mfma_f32_16x16x32_bf16(kf[kb][ks], qf[qb][ks], a, 0, 0, 0);
                    st[kb][qb] = a; }
            asm volatile("" ::: "memory");
            if (t1 < ntile) {
#pragma unroll
                for (int kb = 0; kb < 4; ++kb)
#pragma unroll
                    for (int ks = 0; ks < 2; ++ks) kf[kb][ks] = *(const bf16x8*)(Z + (size_t)(mk1 + 16 * kb + fr) * ZP + ZK + h * 64 + ks * 32 + fq * 8); }
            if (win) { const LAS float* bt = rpbL + (h * 15 + (r0 + t - r + 7)) * 31 + 15;
#pragma unroll
                for (int qb = 0; qb < 2; ++qb) { const int qc = 32 * qh + 16 * qb + fr;
#pragma unroll
                    for (int kb = 0; kb < 4; ++kb)
#pragma unroll
                        for (int rg = 0; rg < 4; ++rg) { const int kc = 16 * kb + 4 * fq + rg; const bool ok = (kc >= c0q[qb]) && (kc < c0q[qb] + 16);
                            const int bi = min(max(kc - qc, -15), 15);
                            st[kb][qb][rg] = ok ? st[kb][qb][rg] * 0.125f + bt[bi] : -1e30f; } }
            } else {
#pragma unroll
                for (int qb = 0; qb < 2; ++qb)
#pragma unroll
                    for (int kb = 0; kb < 4; ++kb) st[kb][qb] = st[kb][qb] * 0.125f;
            }
            bf16x8 pf[2][2];
#pragma unroll
            for (int qb = 0; qb < 2; ++qb) {
                float tm = -1e30f;
#pragma unroll
                for (int kb = 0; kb < 4; ++kb) tm = fmaxf(tm, fmaxf(fmaxf(st[kb][qb][0], st[kb][qb][1]), fmaxf(st[kb][qb][2], st[kb][qb][3])));
                tm = fmaxf(tm, __shfl_xor(tm, 16)); tm = fmaxf(tm, __shfl_xor(tm, 32));
                const float mn = fmaxf(mrun[qb], tm), corr = __expf(mrun[qb] - mn); mrun[qb] = mn;
                float ps = 0.f;
#pragma unroll
                for (int kb = 0; kb < 4; ++kb)
#pragma unroll
                    for (int rg = 0; rg < 4; ++rg) { const float p = __expf(st[kb][qb][rg] - mn); st[kb][qb][rg] = p; ps += p; }
                lrun[qb] = lrun[qb] * corr + ps;
#pragma unroll
                for (int db = 0; db < 4; ++db) ot[db][qb] = ot[db][qb] * corr;
#pragma unroll
                for (int ks = 0; ks < 2; ++ks) { u32x4 w; w.x = pk2(st[2 * ks][qb][0], st[2 * ks][qb][1]); w.y = pk2(st[2 * ks][qb][2], st[2 * ks][qb][3]);
                    w.z = pk2(st[2 * ks + 1][qb][0], st[2 * ks + 1][qb][1]); w.w = pk2(st[2 * ks + 1][qb][2], st[2 * ks + 1][qb][3]); pf[qb][ks] = __builtin_bit_cast(bf16x8, w); }
            }
            const LAS unsigned char* vb = C.lds + (t & 1) * NA_VBUF + (h * 64) * NA_VSTR;
#pragma unroll
            for (int db = 0; db < 4; ++db)
#pragma unroll
                for (int ks = 0; ks < 2; ++ks) { const LAS unsigned char* vp = vb + (16 * db + fr) * NA_VSTR + (32 * ks + 4 * fq) * 2;
                    const u32x2 lo = *(const LAS u32x2*)vp, hi = *(const LAS u32x2*)(vp + 32);
                    u32x4 w; w.x = lo.x; w.y = lo.y; w.z = hi.x; w.w = hi.y; const bf16x8 vf = __builtin_bit_cast(bf16x8, w);
#pragma unroll
                    for (int qb = 0; qb < 2; ++qb) ot[db][qb] = __builtin_amdgcn_mfma_f32_16x16x32_bf16(vf, pf[qb][ks], ot[db][qb], 0, 0, 0); }
            if (t + 1 < ntile) na_vstore(C.lds + ((t + 1) & 1) * NA_VBUF, wave, lane, vr);
            __syncthreads();
        }
#pragma unroll
        for (int qb = 0; qb < 2; ++qb) { float lt = lrun[qb]; lt += __shfl_xor(lt, 16); lt += __shfl_xor(lt, 32); const float inv = 1.f / lt;
            bf16_t* yp = Y + (size_t)(mq0 + 32 * qh + 16 * qb + fr) * 1024 + h * 64 + 4 * fq;
#pragma unroll
            for (int db = 0; db < 4; ++db) { u32x2 w; w.x = pk2(ot[db][qb][0] * inv, ot[db][qb][1] * inv); w.y = pk2(ot[db][qb][2] * inv, ot[db][qb][3] * inv); *(u32x2*)(yp + 16 * db) = w; } }
    }
    __syncthreads();
}


constexpr size_t WS_ROPE = 45 * MiB + 768 * 1024;
constexpr int GV_STR = 136;
constexpr int GQ_STR = 72;
__device__ __forceinline__ void phase_rope_tab(const Ctx& C) {
    float* T = WSP(float, WS_ROPE);
    for (int i = C.bid * NT + C.tid; i < 512; i += C.nb * NT) { const int pos = i >> 3, f = i & 7; const float ang = (float)pos * __expf(-(float)f * (4.605170185988092f / 8.f));
        T[2 * i] = cosf(ang); T[2 * i + 1] = sinf(ang); }
}
template <bool NEED_Q>
__device__ __forceinline__ void gla_prep2(const Ctx& C, int l, int cid, int h, int dir, float (&b)[32], float (&q)[32], float (&k)[32]) {
    const bf16_t* Z = WSP(bf16_t, B_Z);
    const int lane = C.lane; const bf16_t* zr = Z + (size_t)(cid * 64 + lane) * ZP;
    float lo[16];
    { const u32x4* lp = (const u32x4*)(zr + ZLO + dir * 16); unpack8(lp[0], lo); unpack8(lp[1], lo + 8); }
    const float* gup = C.a->in[I_GUP] + (size_t)((l * 2 + dir) * 16) * 128 + h * 32; const float* gb = C.a->in[I_GB] + (size_t)(l * 2 + dir) * 128 + h * 32;
    float G[8];
#pragma unroll
    for (int kk = 0; kk < 8; ++kk) { const int f = kk * 64 + lane; G[kk] = gup[(f >> 5) * 128 + (f & 31)]; }
    const float GB = gb[lane & 31];
#pragma unroll
    for (int d = 0; d < 32; ++d) { float x = rdlane(GB, d);
#pragma unroll
        for (int r = 0; r < 16; ++r) { const int f = r * 32 + d; x += lo[r] * rdlane(G[f >> 6], f & 63); }
        b[d] = logsig16(x); }
    if (dir == 0) {
#pragma unroll
        for (int off = 1; off < 64; off <<= 1) {
#pragma unroll
            for (int d = 0; d < 32; ++d) { const float t = __shfl_up(b[d], off); if (lane >= off) b[d] += t; } }
    } else {
#pragma unroll
        for (int off = 1; off < 64; off <<= 1) {
#pragma unroll
            for (int d = 0; d < 32; ++d) { const float t = __shfl_down(b[d], off); if (lane + off < 64) b[d] += t; } }
    }
    { const u32x4* kp = (const u32x4*)(zr + ZGK + h * 32);
#pragma unroll
      for (int i = 0; i < 4; ++i) unpack8(kp[i], k + 8 * i); }
    if (NEED_Q) { const u32x4* qp = (const u32x4*)(zr + ZGQ + h * 32);
#pragma unroll
      for (int i = 0; i < 4; ++i) unpack8(qp[i], q + 8 * i);
#pragma unroll
      for (int d = 0; d < 32; ++d) q[d] *= 0.17677669529663687f; }
    if (cid < 512) {
        const float* T = WSP(float, WS_ROPE);
#pragma unroll
        for (int hh = 0; hh < 2; ++hh) { const int pos = hh ? lane : (cid & 63); const f32x4* tp = (const f32x4*)(T + pos * 16);
#pragma unroll
            for (int i2 = 0; i2 < 4; ++i2) { const f32x4 cs2 = tp[i2];
#pragma unroll
                for (int u = 0; u < 2; ++u) { const int i = 2 * i2 + u; const float cs = cs2[2 * u], sn = cs2[2 * u + 1]; const int d1 = hh * 16 + i, d2 = d1 + 8;
                    { const float x1 = k[d1], x2 = k[d2]; k[d1] = x1 * cs - x2 * sn; k[d2] = x1 * sn + x2 * cs; }
                    if (NEED_Q) { const float x1 = q[d1], x2 = q[d2]; q[d1] = x1 * cs - x2 * sn; q[d2] = x1 * sn + x2 * cs; } } } }
    }
}
__device__ __forceinline__ void gla_stage_vT(const Ctx& C, LAS unsigned char* vT, int cid, int h) {
    const bf16_t* Z = WSP(bf16_t, B_Z); const int lane = C.lane;
    const u32x4* vp = (const u32x4*)(Z + (size_t)(cid * 64 + lane) * ZP + ZGV + h * 64);
#pragma unroll
    for (int c8 = 0; c8 < 8; ++c8) { const u32x4 w = vp[c8]; LAS unsigned char* p = vT + (c8 * 8) * GV_STR + lane * 2;
        *(LAS bf16_t*)(p + 0 * GV_STR) = (bf16_t)(w.x & 0xffffu); *(LAS bf16_t*)(p + 1 * GV_STR) = (bf16_t)(w.x >> 16); *(LAS bf16_t*)(p + 2 * GV_STR) = (bf16_t)(w.y & 0xffffu); *(LAS bf16_t*)(p + 3 * GV_STR) = (bf16_t)(w.y >> 16);
        *(LAS bf16_t*)(p + 4 * GV_STR) = (bf16_t)(w.z & 0xffffu); *(LAS bf16_t*)(p + 5 * GV_STR) = (bf16_t)(w.z >> 16); *(LAS bf16_t*)(p + 6 * GV_STR) = (bf16_t)(w.w & 0xffffu); *(LAS bf16_t*)(p + 7 * GV_STR) = (bf16_t)(w.w >> 16); }
}
__device__ __forceinline__ bf16x8 lds_frag2(const LAS unsigned char* p0, const LAS unsigned char* p1) { const u32x2 a = *(const LAS u32x2*)p0, b = *(const LAS u32x2*)p1; u32x4 w; w.x = a.x; w.y = a.y; w.z = b.x; w.w = b.y; return __builtin_bit_cast(bf16x8, w); }
__device__ __forceinline__ void phase_gla_a2(const Ctx& C, int l) {
    float* U = WSP(float, B_U); float* DEC = WSP(float, B_DEC);
    float* BF = WSP(float, B_AF); float* BB = WSP(float, B_AB); bf16_t* QP = WSP(bf16_t, B_QP); bf16_t* KP = WSP(bf16_t, B_KP);
    LAS unsigned char* vT = C.lds + C.wave * 18432; LAS unsigned char* keT = vT + 64 * GV_STR;
    const int nw = C.nb * 8, lane = C.lane, fr = lane & 15, fq = lane >> 4;
    for (int item = C.wave * C.nb + (C.bid + C.nb - (144 % C.nb)) % C.nb; item < 544 * 4; item += nw) {
        const int cid = item >> 2, h = item & 3;
        gla_stage_vT(C, vT, cid, h);
#pragma unroll 1
        for (int dir = 0; dir < 2; ++dir) {
            const size_t ro = (size_t)(cid * 64 + lane) * 128 + h * 32;
            if (dir == 0) {
                float q[32]; const bf16_t* zr = WSP(bf16_t, B_Z) + (size_t)(cid * 64 + lane) * ZP; const u32x4* qp = (const u32x4*)(zr + ZGQ + h * 32);
#pragma unroll
                for (int i = 0; i < 4; ++i) unpack8(qp[i], q + 8 * i);
#pragma unroll
                for (int d = 0; d < 32; ++d) q[d] *= 0.17677669529663687f;
                if (cid < 512) { const float* T = WSP(float, WS_ROPE);
#pragma unroll
                    for (int hh = 0; hh < 2; ++hh) { const int pos = hh ? lane : (cid & 63); const f32x4* tp = (const f32x4*)(T + pos * 16);
#pragma unroll
                        for (int i2 = 0; i2 < 4; ++i2) { const f32x4 cs2 = tp[i2];
#pragma unroll
                            for (int u = 0; u < 2; ++u) { const int i = 2 * i2 + u; const float cs = cs2[2 * u], sn = cs2[2 * u + 1]; const int d1 = hh * 16 + i, d2 = d1 + 8;
                                const float x1 = q[d1], x2 = q[d2]; q[d1] = x1 * cs - x2 * sn; q[d2] = x1 * sn + x2 * cs; } } } }
#pragma unroll
                for (int i = 0; i < 4; ++i) { u32x4 w; w.x = pk2(q[8 * i], q[8 * i + 1]); w.y = pk2(q[8 * i + 2], q[8 * i + 3]); w.z = pk2(q[8 * i + 4], q[8 * i + 5]); w.w = pk2(q[8 * i + 6], q[8 * i + 7]); *(u32x4*)(QP + ro + 8 * i) = w; }
                asm volatile("" ::: "memory");
            }
            float b[32], k[32], qdummy[32];
            gla_prep2<false>(C, l, cid, h, dir, b, qdummy, k);
            { float* bp = (dir ? BB : BF) + ro;
#pragma unroll
              for (int i = 0; i < 8; ++i) *(f32x4*)(bp + 4 * i) = (f32x4){b[4 * i], b[4 * i + 1], b[4 * i + 2], b[4 * i + 3]}; }
            if (dir == 0) {
#pragma unroll
                for (int i = 0; i < 4; ++i) { u32x4 x; x.x = pk2(k[8 * i], k[8 * i + 1]); x.y = pk2(k[8 * i + 2], k[8 * i + 3]); x.z = pk2(k[8 * i + 4], k[8 * i + 5]); x.w = pk2(k[8 * i + 6], k[8 * i + 7]); *(u32x4*)(KP + ro + 8 * i) = x; } }
            float tot[32];
#pragma unroll
            for (int d = 0; d < 32; ++d) { tot[d] = rdlane(b[d], dir ? 0 : 63); *(LAS bf16_t*)(keT + d * GV_STR + lane * 2) = (bf16_t)f2bf(k[d] * __expf(tot[d] - b[d])); }
            wave_sync();
            f32x4 acc[4][2];
#pragma unroll
            for (int eb = 0; eb < 4; ++eb)
#pragma unroll
                for (int db = 0; db < 2; ++db) acc[eb][db] = (f32x4){0.f, 0.f, 0.f, 0.f};
#pragma unroll
            for (int ks = 0; ks < 2; ++ks) { bf16x8 vf[4], kf[2];
#pragma unroll
                for (int eb = 0; eb < 4; ++eb) { const LAS unsigned char* p = vT + (16 * eb + fr) * GV_STR + (32 * ks + 8 * fq) * 2; vf[eb] = lds_frag2(p, p + 8); }
#pragma unroll
                for (int db = 0; db < 2; ++db) { const LAS unsigned char* p = keT + (16 * db + fr) * GV_STR + (32 * ks + 8 * fq) * 2; kf[db] = lds_frag2(p, p + 8); }
#pragma unroll
                for (int eb = 0; eb < 4; ++eb)
#pragma unroll
                    for (int db = 0; db < 2; ++db) acc[eb][db] = __builtin_amdgcn_mfma_f32_16x16x32_bf16(vf[eb], kf[db], acc[eb][db], 0, 0, 0); }
            const size_t off = (size_t)((cid * 4 + h) * 2 + dir);
#pragma unroll
            for (int eb = 0; eb < 4; ++eb)
#pragma unroll
                for (int db = 0; db < 2; ++db)
#pragma unroll
                    for (int rg = 0; rg < 4; ++rg) U[off * 2048 + (16 * eb + 4 * fq + rg) * 32 + 16 * db + fr] = acc[eb][db][rg];
            if (lane < 32) { float dv = 0.f;
#pragma unroll
                for (int d = 0; d < 32; ++d) dv = (lane == d) ? tot[d] : dv;
                DEC[off * 32 + lane] = __expf(dv); }
            wave_sync();
        }
    }
}
__device__ __forceinline__ void phase_gla_scan2(const Ctx& C) {
    float* U = WSP(float, B_U); const float* DEC = WSP(float, B_DEC);
    for (int idx = C.bid * NT + C.tid; idx < 64 * 2048; idx += C.nb * NT) {
        const int chain = idx >> 11, de = idx & 2047, d = de & 31, b = chain >> 3, h = (chain >> 1) & 3, dir = chain & 1;
        float s = 0.f;
        for (int st = 0; st < 68; st += 17) {
            size_t off[17]; float tmp[17], dc[17];
#pragma unroll
            for (int j = 0; j < 17; ++j) { const int step = st + j; int cid;
                if (step < 4) cid = 512 + b * 4 + (dir ? 3 - step : step); else { const int n = step - 4; cid = b * 64 + (dir ? 63 - n : n); }
                off[j] = (size_t)((cid * 4 + h) * 2 + dir); tmp[j] = U[off[j] * 2048 + de]; dc[j] = DEC[off[j] * 32 + d]; }
#pragma unroll
            for (int j = 0; j < 17; ++j) { U[off[j] * 2048 + de] = s; s = dc[j] * s + tmp[j]; }
        }
    }
}
__device__ __forceinline__ void phase_gla_out2(const Ctx& C, int l) {
    const bf16_t* Z = WSP(bf16_t, B_Z); const float* U = WSP(float, B_U); bf16_t* Y = WSP(bf16_t, WS_Y);
    const float* BF = WSP(float, B_AF); const float* BB = WSP(float, B_AB); const bf16_t* QP = WSP(bf16_t, B_QP); const bf16_t* KP = WSP(bf16_t, B_KP);
    const float* ng = C.a->in[I_GNG] + (size_t)l * 256;
    LAS unsigned char* vT = C.lds + C.wave * 18432; LAS unsigned char* qsR = vT + 64 * GV_STR; LAS unsigned char* ksR = qsR + 64 * GQ_STR;
    const int nitems = (l == 0 ? 544 : 512) * 4, nw = C.nb * 8, lane = C.lane, fr = lane & 15, fq = lane >> 4;
    for (int item = C.wave * C.nb + C.bid; item < nitems; item += nw) {
        const int cid = item >> 2, h = item & 3;
        gla_stage_vT(C, vT, cid, h);
        f32x4 oT[4][4];
#pragma unroll
        for (int eb = 0; eb < 4; ++eb)
#pragma unroll
            for (int cb = 0; cb < 4; ++cb) oT[eb][cb] = (f32x4){0.f, 0.f, 0.f, 0.f};
#pragma unroll 1
        for (int dir = 0; dir < 2; ++dir) {
            {
                const size_t ro = (size_t)(cid * 64 + lane) * 128 + h * 32; const float* bp = (dir ? BB : BF) + ro;
#pragma unroll
                for (int i = 0; i < 4; ++i) { const f32x4 b0 = *(const f32x4*)(bp + 8 * i), b1 = *(const f32x4*)(bp + 8 * i + 4); const u32x4 qw = *(const u32x4*)(QP + ro + 8 * i), kw = *(const u32x4*)(KP + ro + 8 * i);
                    float qv[8], kv[8], eb8[8]; unpack8(qw, qv); unpack8(kw, kv);
#pragma unroll
                    for (int j = 0; j < 4; ++j) { eb8[j] = __expf(b0[j]); eb8[4 + j] = __expf(b1[j]); }
                    u32x2 w0, w1, x0, x1;
                    w0.x = pk2(qv[0] * eb8[0], qv[1] * eb8[1]); w0.y = pk2(qv[2] * eb8[2], qv[3] * eb8[3]); w1.x = pk2(qv[4] * eb8[4], qv[5] * eb8[5]); w1.y = pk2(qv[6] * eb8[6], qv[7] * eb8[7]);
                    x0.x = pk2(kv[0] * __builtin_amdgcn_rcpf(eb8[0]), kv[1] * __builtin_amdgcn_rcpf(eb8[1])); x0.y = pk2(kv[2] * __builtin_amdgcn_rcpf(eb8[2]), kv[3] * __builtin_amdgcn_rcpf(eb8[3]));
                    x1.x = pk2(kv[4] * __builtin_amdgcn_rcpf(eb8[4]), kv[5] * __builtin_amdgcn_rcpf(eb8[5])); x1.y = pk2(kv[6] * __builtin_amdgcn_rcpf(eb8[6]), kv[7] * __builtin_amdgcn_rcpf(eb8[7]));
                    *(LAS u32x2*)(qsR + lane * GQ_STR + 16 * i) = w0; *(LAS u32x2*)(qsR + lane * GQ_STR + 16 * i + 8) = w1;
                    *(LAS u32x2*)(ksR + lane * GQ_STR + 16 * i) = x0; *(LAS u32x2*)(ksR + lane * GQ_STR + 16 * i + 8) = x1; }
            }
            wave_sync();
            bf16x8 vf[4][2], sf[4];
#pragma unroll
            for (int eb = 0; eb < 4; ++eb) {
#pragma unroll
                for (int ks = 0; ks < 2; ++ks) { const LAS unsigned char* p = vT + (16 * eb + fr) * GV_STR + (32 * ks + 4 * fq) * 2; vf[eb][ks] = lds_frag2(p, p + 32); }
                const float* sp = U + (size_t)((cid * 4 + h) * 2 + dir) * 2048 + (16 * eb + fr) * 32 + 8 * fq; const f32x4 s0 = *(const f32x4*)sp, s1 = *(const f32x4*)(sp + 4);
                u32x4 w; w.x = pk2(s0[0], s0[1]); w.y = pk2(s0[2], s0[3]); w.z = pk2(s1[0], s1[1]); w.w = pk2(s1[2], s1[3]); sf[eb] = __builtin_bit_cast(bf16x8, w); }
            bf16x8 kfr[4];
#pragma unroll
            for (int sb = 0; sb < 4; ++sb) { const LAS unsigned char* p = ksR + (16 * sb + fr) * GQ_STR + 16 * fq; kfr[sb] = lds_frag2(p, p + 8); }
#pragma unroll
            for (int cb = 0; cb < 4; ++cb) {
                const LAS unsigned char* p = qsR + (16 * cb + fr) * GQ_STR + 16 * fq; const bf16x8 qf = lds_frag2(p, p + 8);
                f32x4 at[4];
#pragma unroll
                for (int sb = 0; sb < 4; ++sb) { at[sb] = __builtin_amdgcn_mfma_f32_16x16x32_bf16(kfr[sb], qf, (f32x4){0.f, 0.f, 0.f, 0.f}, 0, 0, 0);
#pragma unroll
                    for (int rg = 0; rg < 4; ++rg) { const int sI = 16 * sb + 4 * fq + rg, cI = 16 * cb + fr; const bool ok = dir ? (sI >= cI) : (sI <= cI); at[sb][rg] = ok ? at[sb][rg] : 0.f; } }
#pragma unroll
                for (int ks = 0; ks < 2; ++ks) { u32x4 w; w.x = pk2(at[2 * ks][0], at[2 * ks][1]); w.y = pk2(at[2 * ks][2], at[2 * ks][3]); w.z = pk2(at[2 * ks + 1][0], at[2 * ks + 1][1]); w.w = pk2(at[2 * ks + 1][2], at[2 * ks + 1][3]);
                    const bf16x8 pf = __builtin_bit_cast(bf16x8, w);
#pragma unroll
                    for (int eb = 0; eb < 4; ++eb) oT[eb][cb] = __builtin_amdgcn_mfma_f32_16x16x32_bf16(vf[eb][ks], pf, oT[eb][cb], 0, 0, 0); }
#pragma unroll
                for (int eb = 0; eb < 4; ++eb) oT[eb][cb] = __builtin_amdgcn_mfma_f32_16x16x32_bf16(sf[eb], qf, oT[eb][cb], 0, 0, 0);
            }
            wave_sync();
        }
#pragma unroll
        for (int cb = 0; cb < 4; ++cb) { float ss = 0.f;
#pragma unroll
            for (int eb = 0; eb < 4; ++eb) ss += (oT[eb][cb][0] * oT[eb][cb][0] + oT[eb][cb][1] * oT[eb][cb][1]) + (oT[eb][cb][2] * oT[eb][cb][2] + oT[eb][cb][3] * oT[eb][cb][3]);
            ss += __shfl_xor(ss, 16); ss += __shfl_xor(ss, 32);
            const float rs = rsqrtf(ss * (1.f / 64.f) + LN_EPS);
            const size_t m = (size_t)(cid * 64 + 16 * cb + fr);
#pragma unroll
            for (int eb = 0; eb < 4; ++eb) { const int e0 = h * 64 + 16 * eb + 4 * fq; const u32x2 rr = *(const u32x2*)(Z + m * ZP + ZGR + e0); const f32x4 g4 = *(const f32x4*)(ng + e0);
                const float y0 = oT[eb][cb][0] * rs * g4[0] * siluf_(lo16(rr.x)), y1 = oT[eb][cb][1] * rs * g4[1] * siluf_(hi16(rr.x)), y2 = oT[eb][cb][2] * rs * g4[2] * siluf_(lo16(rr.y)), y3 = oT[eb][cb][3] * rs * g4[3] * siluf_(hi16(rr.y));
                u32x2 w; w.x = pk2(y0, y1); w.y = pk2(y2, y3); *(u32x2*)(Y + m * 1024 + 256 + e0) = w; } }
    }
}

__device__ __forceinline__ void phase_na(const Ctx& C, int l) {
    const bf16_t* Z = WSP(bf16_t, B_Z); bf16_t* Y = WSP(bf16_t, WS_Y);
    const float* rpb = C.a->in[I_RPB] + (size_t)l * 4 * 15 * 31;
    const int total = 4 * M_ALL;
    for (int idx = C.bid * NT + C.tid; idx < total; idx += C.nb * NT) {
        const int h = idx / M_ALL, m = idx % M_ALL;
        float q[64], acc[64];
        { const u32x4* qp = (const u32x4*)(Z + (size_t)m * ZP + ZQ + h * 64);
#pragma unroll
          for (int i = 0; i < 8; ++i) { const u32x4 v = qp[i]; q[8 * i + 0] = lo16(v.x) * 0.125f; q[8 * i + 1] = hi16(v.x) * 0.125f; q[8 * i + 2] = lo16(v.y) * 0.125f; q[8 * i + 3] = hi16(v.y) * 0.125f;
              q[8 * i + 4] = lo16(v.z) * 0.125f; q[8 * i + 5] = hi16(v.z) * 0.125f; q[8 * i + 6] = lo16(v.w) * 0.125f; q[8 * i + 7] = hi16(v.w) * 0.125f; } }
#pragma unroll
        for (int i = 0; i < 64; ++i) acc[i] = 0.f;
        float mx = -1e30f, den = 0.f;
        int b, nwin = 0, r = 0, cq = 0, r0 = 0, c0 = 0;
        if (m < M_LAT) { b = m >> 12; const int t = m & 4095; r = t >> 6; cq = t & 63; r0 = min(max(r - 4, 0), 56); c0 = min(max(cq - 8, 0), 48); nwin = 128; }
        else b = (m - M_LAT) >> 8;
        for (int kk = 0; kk < nwin + CTXL; ++kk) {
            int mk; float bias = 0.f;
            if (kk < nwin) { const int kr = r0 + (kk >> 4), kc = c0 + (kk & 15); mk = b * SEQ + kr * 64 + kc; bias = rpb[(h * 15 + (kr - r + 7)) * 31 + (kc - cq + 15)]; }
            else mk = M_LAT + b * CTXL + (kk - nwin);
            const u32x4* kp = (const u32x4*)(Z + (size_t)mk * ZP + ZK + h * 64);
            float s = 0.f;
#pragma unroll
            for (int i = 0; i < 8; ++i) { const u32x4 v = kp[i]; s += q[8 * i + 0] * lo16(v.x) + q[8 * i + 1] * hi16(v.x) + q[8 * i + 2] * lo16(v.y) + q[8 * i + 3] * hi16(v.y)
                  + q[8 * i + 4] * lo16(v.z) + q[8 * i + 5] * hi16(v.z) + q[8 * i + 6] * lo16(v.w) + q[8 * i + 7] * hi16(v.w); }
            s += bias;
            const float mn = fmaxf(mx, s), corr = __expf(mx - mn), p = __expf(s - mn);
            den = den * corr + p; mx = mn;
            const u32x4* vp = (const u32x4*)(Z + (size_t)mk * ZP + ZV + h * 64);
#pragma unroll
            for (int i = 0; i < 8; ++i) { const u32x4 v = vp[i];
                acc[8 * i + 0] = acc[8 * i + 0] * corr + p * lo16(v.x); acc[8 * i + 1] = acc[8 * i + 1] * corr + p * hi16(v.x); acc[8 * i + 2] = acc[8 * i + 2] * corr + p * lo16(v.y); acc[8 * i + 3] = acc[8 * i + 3] * corr + p * hi16(v.y);
                acc[8 * i + 4] = acc[8 * i + 4] * corr + p * lo16(v.z); acc[8 * i + 5] = acc[8 * i + 5] * corr + p * hi16(v.z); acc[8 * i + 6] = acc[8 * i + 6] * corr + p * lo16(v.w); acc[8 * i + 7] = acc[8 * i + 7] * corr + p * hi16(v.w); }
        }
        const float inv = 1.f / den;
        u32x4* yp = (u32x4*)(Y + (size_t)m * 1024 + h * 64);
#pragma unroll
        for (int i = 0; i < 8; ++i) { u32x4 w; w.x = pk2(acc[8 * i] * inv, acc[8 * i + 1] * inv); w.y = pk2(acc[8 * i + 2] * inv, acc[8 * i + 3] * inv); w.z = pk2(acc[8 * i + 4] * inv, acc[8 * i + 5] * inv); w.w = pk2(acc[8 * i + 6] * inv, acc[8 * i + 7] * inv); yp[i] = w; }
    }
}
__device__ __forceinline__ void phase_conv(const Ctx& C, int l) {
    const bf16_t* Z = WSP(bf16_t, B_Z); bf16_t* Y = WSP(bf16_t, WS_Y);
    const float* dw = C.a->in[I_CDW] + (size_t)l * 31 * 256; const float* cb = C.a->in[I_CB] + l * 256; const float* lg = C.a->in[I_CLG] + l * 256; const float* lb = C.a->in[I_CLB] + l * 256;
    for (int m = C.bid * 8 + C.wave; m < M_ALL; m += C.nb * 8) {
        int base, pos, len;
        if (m < M_LAT) { base = m & ~4095; pos = m & 4095; len = SEQ; } else { base = M_LAT + ((m - M_LAT) & ~255); pos = (m - M_LAT) & 255; len = CTXL; }
        float y[4];
#pragma unroll
        for (int i = 0; i < 4; ++i) y[i] = cb[C.lane + 64 * i];
        for (int j = 0; j < 31; ++j) { const int p = pos + j - 15; if (p < 0 || p >= len) continue;
            const bf16_t* zr = Z + (size_t)(base + p) * ZP;
#pragma unroll
            for (int i = 0; i < 4; ++i) { const int ch = C.lane + 64 * i; const float a = bf2f(zr[ZCA + ch]), g = bf2f(zr[ZCG + ch]); y[i] += dw[j * 256 + ch] * a * sigmoidf_(g); } }
        const float mu = wave_sum(y[0] + y[1] + y[2] + y[3]) * (1.f / 256.f);
        float q = 0.f;
#pragma unroll
        for (int i = 0; i < 4; ++i) { y[i] -= mu; q += y[i] * y[i]; }
        const float rs = rsqrtf(wave_sum(q) * (1.f / 256.f) + LN_EPS);
#pragma unroll
        for (int i = 0; i < 4; ++i) { const int ch = C.lane + 64 * i; const float v = y[i] * rs * lg[ch] + lb[ch]; Y[(size_t)m * 1024 + 512 + ch] = (bf16_t)f2bf(siluf_(v)); }
    }
}

__device__ __forceinline__ void phase_conv2(const Ctx& C, int l) {
    const bf16_t* Z = WSP(bf16_t, B_Z); bf16_t* Y = WSP(bf16_t, WS_Y);
    const float* dw = C.a->in[I_CDW] + (size_t)l * 31 * 256; const float* cb = C.a->in[I_CB] + l * 256; const float* lg = C.a->in[I_CLG] + l * 256; const float* lb = C.a->in[I_CLB] + l * 256;
    LAS float* tile = (LAS float*)C.lds;
    LAS float* co = (LAS float*)(C.lds + 65536);
    const int nunits = (l == 0) ? 1088 : 1024;
    for (int unit = (C.bid + C.nb - (64 % C.nb)) % C.nb; unit < nunits; unit += C.nb) {
        int base, p0, len;
        if (unit < 1024) { base = (unit >> 7) * SEQ; p0 = (unit & 127) * 32; len = SEQ; } else { const int uc = unit - 1024; base = M_LAT + (uc >> 3) * CTXL; p0 = (uc & 7) * 32; len = CTXL; }
        {
            u32x4 av[4], gv[4]; bool okv[4];
#pragma unroll
            for (int i = 0; i < 4; ++i) { const int c = C.tid + i * NT; const int rr = c >> 5, c8 = (c & 31) * 8; const int p = p0 - 15 + rr; okv[i] = (c < 62 * 32) && p >= 0 && p < len;
                av[i] = (u32x4){0u, 0u, 0u, 0u}; gv[i] = av[i];
                if (okv[i]) { const bf16_t* zr = Z + (size_t)(base + p) * ZP; av[i] = *(const u32x4*)(zr + ZCA + c8); gv[i] = *(const u32x4*)(zr + ZCG + c8); } }
#pragma unroll
            for (int i = 0; i < 4; ++i) { const int c = C.tid + i * NT; if (c >= 62 * 32) continue; const int rr = c >> 5, c8 = (c & 31) * 8;
                f32x4 o0 = (f32x4){0.f, 0.f, 0.f, 0.f}, o1 = o0; const u32x4 a = av[i], g = gv[i];
                if (okv[i]) {
                    o0[0] = lo16(a.x) * sigmoidf_(lo16(g.x)); o0[1] = hi16(a.x) * sigmoidf_(hi16(g.x)); o0[2] = lo16(a.y) * sigmoidf_(lo16(g.y)); o0[3] = hi16(a.y) * sigmoidf_(hi16(g.y));
                    o1[0] = lo16(a.z) * sigmoidf_(lo16(g.z)); o1[1] = hi16(a.z) * sigmoidf_(hi16(g.z)); o1[2] = lo16(a.w) * sigmoidf_(lo16(g.w)); o1[3] = hi16(a.w) * sigmoidf_(hi16(g.w)); }
                *(LAS f32x4*)(tile + rr * 256 + c8) = o0; *(LAS f32x4*)(tile + rr * 256 + c8 + 4) = o1; }
        }
        __syncthreads();
        { const int ch = C.tid & 255, hf = C.tid >> 8;
          float w[31];
#pragma unroll
          for (int j = 0; j < 31; ++j) w[j] = dw[j * 256 + ch];
          float in[46];
#pragma unroll
          for (int i = 0; i < 46; ++i) in[i] = tile[(hf * 16 + i) * 256 + ch];
          const float bias = cb[ch];
#pragma unroll
          for (int o = 0; o < 16; ++o) { float y = bias;
#pragma unroll
              for (int j = 0; j < 31; ++j) y += w[j] * in[o + j];
              co[(hf * 16 + o) * 256 + ch] = y; } }
        __syncthreads();
#pragma unroll
        for (int k = 0; k < 4; ++k) { const int tk = C.wave * 4 + k; const int c0 = 4 * C.lane;
            f32x4 y = *(const LAS f32x4*)(co + tk * 256 + c0);
            const float mu = wave_sum((y[0] + y[1]) + (y[2] + y[3])) * (1.f / 256.f);
            y = y - mu;
            const float rs = rsqrtf(wave_sum((y[0] * y[0] + y[1] * y[1]) + (y[2] * y[2] + y[3] * y[3])) * (1.f / 256.f) + LN_EPS);
            const f32x4 gg = *(const f32x4*)(lg + c0), bb = *(const f32x4*)(lb + c0);
            float o[4];
#pragma unroll
            for (int i = 0; i < 4; ++i) o[i] = siluf_(y[i] * rs * gg[i] + bb[i]);
            u32x2 wv; wv.x = pk2(o[0], o[1]); wv.y = pk2(o[2], o[3]); *(u32x2*)(Y + (size_t)(base + p0 + tk) * 1024 + 512 + c0) = wv; }
        __syncthreads();
    }
}

__device__ __forceinline__ void phase_sgu1(const Ctx& C, int l) {
    const bf16_t* Z = WSP(bf16_t, B_Z); float* VN = WSP(float, B_VN);
    const float* lg = C.a->in[I_SLG] + l * 256; const float* lb = C.a->in[I_SLB] + l * 256;
    for (int m = C.bid * 8 + C.wave; m < M_ALL; m += C.nb * 8) {
        const int c0 = 4 * C.lane; const u32x2 zz = *(const u32x2*)(Z + (size_t)m * ZP + ZSV + c0);
        float v[4] = {gelu_tanh(lo16(zz.x)), gelu_tanh(hi16(zz.x)), gelu_tanh(lo16(zz.y)), gelu_tanh(hi16(zz.y))};
        const float mu = wave_sum(v[0] + v[1] + v[2] + v[3]) * (1.f / 256.f);
        float q = 0.f;
#pragma unroll
        for (int i = 0; i < 4; ++i) { v[i] -= mu; q += v[i] * v[i]; }
        const float rs = rsqrtf(wave_sum(q) * (1.f / 256.f) + LN_EPS);
        f32x4 o;
#pragma unroll
        for (int i = 0; i < 4; ++i) o[i] = v[i] * rs * lg[c0 + i] + lb[c0 + i];
        *(f32x4*)(VN + (size_t)m * 256 + c0) = o;
    }
}
__device__ __forceinline__ void phase_sgu2(const Ctx& C, int l) {
    const bf16_t* Z = WSP(bf16_t, B_Z); const float* VN = WSP(float, B_VN); bf16_t* Y = WSP(bf16_t, WS_Y);
    const float* ws = C.a->in[I_SWS] + (size_t)l * 4 * 128 * 128; const float* bs = C.a->in[I_SBS] + (size_t)l * 4 * 128;
    const long total = (long)M_ALL * 256;
    for (long idx = (long)C.bid * NT + C.tid; idx < total; idx += (long)C.nb * NT) {
        const int m = (int)(idx >> 8), ch = (int)(idx & 255), g = ch >> 6, p = m & 127, mb = m & ~127;
        const float* wr = ws + (size_t)(g * 128 + p) * 128; const float* vb = VN + (size_t)mb * 256 + ch;
        float s = bs[g * 128 + p];
#pragma unroll 8
        for (int q = 0; q < 128; ++q) s += wr[q] * vb[(size_t)q * 256];
        const float u = gelu_tanh(bf2f(Z[(size_t)m * ZP + ZSU + ch]));
        Y[(size_t)m * 1024 + 768 + ch] = (bf16_t)f2bf(u * s);
    }
}


constexpr size_t WS_WSB = 45 * MiB;
constexpr int VT_STRIDE = 272;
__device__ __forceinline__ void phase_wsb(const Ctx& C) {
    const float* ws = C.a->in[I_SWS]; bf16_t* d = WSP(bf16_t, WS_WSB);
    for (int i = C.bid * NT + C.tid; i < 2 * 4 * 128 * 128; i += C.nb * NT) { d[i] = (bf16_t)f2bf(ws[i]); asm volatile("" : "+v"(i)); }
}
__device__ __forceinline__ void phase_sgu(const Ctx& C, int l) {
    const bf16_t* Z = WSP(bf16_t, B_Z); bf16_t* Y = WSP(bf16_t, WS_Y);
    const float* lg = C.a->in[I_SLG] + l * 256; const float* lb = C.a->in[I_SLB] + l * 256; const float* bs = C.a->in[I_SBS] + (size_t)l * 4 * 128;
    const bf16_t* wsb = WSP(bf16_t, WS_WSB) + (size_t)l * 4 * 128 * 128;
    const int nunits = (l == 0) ? 272 : 256, lane = C.lane, wave = C.wave;
    for (int unit = (C.bid + C.nb - (128 % C.nb)) % C.nb; unit < nunits; unit += C.nb) {
        const int mb = unit * 128;
#pragma unroll 1
        for (int rr = 0; rr < 16; rr += 4) { const int c0 = 4 * lane; u32x2 zz[4];
#pragma unroll
            for (int r = 0; r < 4; ++r) zz[r] = *(const u32x2*)(Z + (size_t)(mb + wave * 16 + rr + r) * ZP + ZSV + c0);
            float v[4][4], mu[4], qq[4];
#pragma unroll
            for (int r = 0; r < 4; ++r) { v[r][0] = gelu_tanh(lo16(zz[r].x)); v[r][1] = gelu_tanh(hi16(zz[r].x)); v[r][2] = gelu_tanh(lo16(zz[r].y)); v[r][3] = gelu_tanh(hi16(zz[r].y)); mu[r] = (v[r][0] + v[r][1]) + (v[r][2] + v[r][3]); }
#pragma unroll
            for (int o = 1; o < 64; o <<= 1) {
#pragma unroll
                for (int r = 0; r < 4; ++r) mu[r] += __shfl_xor(mu[r], o); }
#pragma unroll
            for (int r = 0; r < 4; ++r) { mu[r] *= (1.f / 256.f); qq[r] = 0.f;
#pragma unroll
                for (int i = 0; i < 4; ++i) { v[r][i] -= mu[r]; qq[r] += v[r][i] * v[r][i]; } }
#pragma unroll
            for (int o = 1; o < 64; o <<= 1) {
#pragma unroll
                for (int r = 0; r < 4; ++r) qq[r] += __shfl_xor(qq[r], o); }
#pragma unroll
            for (int r = 0; r < 4; ++r) { const int q = wave * 16 + rr + r; const float rs = rsqrtf(qq[r] * (1.f / 256.f) + LN_EPS);
#pragma unroll
                for (int i = 0; i < 4; ++i) { const float o = v[r][i] * rs * lg[c0 + i] + lb[c0 + i]; *(LAS bf16_t*)(C.lds + (c0 + i) * VT_STRIDE + q * 2) = (bf16_t)f2bf(o); } } }
        __syncthreads();
        const int g = wave >> 1, cbase = g * 64 + (wave & 1) * 32, fr = lane & 15, fq = lane >> 4;
        f32x4 acc[2][8];
#pragma unroll
        for (int cb = 0; cb < 2; ++cb)
#pragma unroll
            for (int pb = 0; pb < 8; ++pb) acc[cb][pb] = (f32x4){0.f, 0.f, 0.f, 0.f};
#pragma unroll
        for (int ks = 0; ks < 4; ++ks) {
            bf16x8 af[2], bfr[8];
#pragma unroll
            for (int cb = 0; cb < 2; ++cb) af[cb] = *(const LAS bf16x8*)(C.lds + (cbase + cb * 16 + fr) * VT_STRIDE + (ks * 32 + fq * 8) * 2);
#pragma unroll
            for (int pb = 0; pb < 8; ++pb) bfr[pb] = *(const bf16x8*)(wsb + (size_t)(g * 128 + pb * 16 + fr) * 128 + ks * 32 + fq * 8);
#pragma unroll
            for (int cb = 0; cb < 2; ++cb)
#pragma unroll
                for (int pb = 0; pb < 8; ++pb) acc[cb][pb] = __builtin_amdgcn_mfma_f32_16x16x32_bf16(af[cb], bfr[pb], acc[cb][pb], 0, 0, 0);
        }
#pragma unroll
        for (int pb = 0; pb < 8; ++pb) { const int p = pb * 16 + fr; const float bsv = bs[g * 128 + p];
#pragma unroll
            for (int cb = 0; cb < 2; ++cb) { const int c = cbase + cb * 16 + 4 * fq;
                const u32x2 uu = *(const u32x2*)(Z + (size_t)(mb + p) * ZP + ZSU + c);
                const float y0 = gelu_tanh(lo16(uu.x)) * (acc[cb][pb][0] + bsv), y1 = gelu_tanh(hi16(uu.x)) * (acc[cb][pb][1] + bsv), y2 = gelu_tanh(lo16(uu.y)) * (acc[cb][pb][2] + bsv), y3 = gelu_tanh(hi16(uu.y)) * (acc[cb][pb][3] + bsv);
                u32x2 w; w.x = pk2(y0, y1); w.y = pk2(y2, y3); *(u32x2*)(Y + (size_t)(mb + p) * 1024 + 768 + c) = w; } }
        __syncthreads();
    }
}

__device__ __forceinline__ float* xrow_out(const Ctx& C, int m) { return m < M_LAT ? C.a->out + (size_t)m * 1024 : WSP(float, WS_XC) + (size_t)(m - M_LAT) * 1024; }
__device__ __forceinline__ const float* xrow_in(const Ctx& C, int l, int m) {
    if (l == 0) return m < M_LAT ? C.a->in[I_X] + (size_t)m * 1024 : C.a->in[I_CTX] + (size_t)(m - M_LAT) * 1024;
    return xrow_out(C, m);
}
__device__ __forceinline__ void phase_ln1(const Ctx& C, int l) {
    const float* MOD = WSP(float, WS_MOD); bf16_t* H = WSP(bf16_t, WS_H);
    const float* g_ = C.a->in[I_LN1G] + l * 1024; const float* b_ = C.a->in[I_LN1B] + l * 1024;
    const int mrows = (l == 0) ? M_ALL : M_LAT;
    for (int m0 = (C.bid * 8 + C.wave) * 4; m0 < mrows; m0 += C.nb * 8 * 4) {
        f32x4 xv[4][4]; u32x2 yv[4][4];
#pragma unroll
        for (int r = 0; r < 4; ++r) { const float* xr = xrow_in(C, l, m0 + r);
#pragma unroll
            for (int j = 0; j < 4; ++j) { const int col = 4 * C.lane + 256 * j; xv[r][j] = __builtin_nontemporal_load((const f32x4*)(xr + col)); yv[r][j] = __builtin_nontemporal_load((const u32x2*)(H + (size_t)(m0 + r) * 1024 + col)); } }
#pragma unroll
        for (int r = 0; r < 4; ++r) { const int m = m0 + r; float* xo = xrow_out(C, m);
            const float* md = MOD + (size_t)(l * 9 + mod_index(m)) * 6144;
            f32x4 v[4]; float s = 0.f;
#pragma unroll
            for (int j = 0; j < 4; ++j) { const int col = 4 * C.lane + 256 * j; const f32x4 g1 = *(const f32x4*)(md + 2048 + col); const u32x2 yy = yv[r][j];
                f32x4 y; y[0] = lo16(yy.x); y[1] = hi16(yy.x); y[2] = lo16(yy.y); y[3] = hi16(yy.y);
                v[j] = xv[r][j] * ALPHA + g1 * y; s += (v[j][0] + v[j][1]) + (v[j][2] + v[j][3]); }
            const float mu = wave_sum(s) * (1.f / 1024.f); float q = 0.f;
#pragma unroll
            for (int j = 0; j < 4; ++j) { v[j] = v[j] - mu; q += (v[j][0] * v[j][0] + v[j][1] * v[j][1]) + (v[j][2] * v[j][2] + v[j][3] * v[j][3]); }
            const float rs = rsqrtf(wave_sum(q) * (1.f / 1024.f) + LN_EPS);
#pragma unroll
            for (int j = 0; j < 4; ++j) { const int col = 4 * C.lane + 256 * j; const f32x4 x1 = v[j] * rs * *(const f32x4*)(g_ + col) + *(const f32x4*)(b_ + col);
                *(f32x4*)(xo + col) = x1;
                const f32x4 h2 = x1 * (*(const f32x4*)(md + 4096 + col) + 1.f) + *(const f32x4*)(md + 3072 + col);
                u32x2 w; w.x = pk2(h2[0], h2[1]); w.y = pk2(h2[2], h2[3]); *(u32x2*)(H + (size_t)m * 1024 + col) = w; } }
    }
}
__device__ __forceinline__ void phase_tables(const Ctx& C, int l) {
    const f32x4* su = (const f32x4*)(C.a->in[I_PU] + (size_t)l * 16384 * 1024); const f32x4* sv = (const f32x4*)(C.a->in[I_PV] + (size_t)l * 16384 * 1024);
    u32x2* du = WSP(u32x2, B_TU); u32x2* dv = WSP(u32x2, B_TV);
    const long n4 = (long)16384 * 1024 / 4;
    for (long i = (long)C.bid * NT + C.tid; i < n4; i += (long)C.nb * NT) {
        const f32x4 a = su[i], b = sv[i]; u32x2 wa, wb; wa.x = pk2(a[0], a[1]); wa.y = pk2(a[2], a[3]); wb.x = pk2(b[0], b[1]); wb.y = pk2(b[2], b[3]); du[i] = wa; dv[i] = wb; }
}
__device__ const unsigned char PAIR_TAB[64] = {0,1,2,3,4,5,6,7,8,9,10,11,12,13,14,15,16,17,18,19,20,21,22,23,32,33,34,35,36,48,49,50,51,64,65,66,80,81,96,97,112,113,128,144,160,176,192,208,224,240, 0,0,0,0,0,0,0,0,0,0,0,0,0,0};
__device__ __forceinline__ unsigned ord16(unsigned h) { return (h & 0x8000u) ? (~h & 0xffffu) : (h | 0x8000u); }
__device__ __forceinline__ float dec16(unsigned key) { const unsigned o = key >> 7; const unsigned short h = (unsigned short)((o & 0x8000u) ? (o & 0x7fffu) : (~o & 0xffffu)); return (float)__builtin_bit_cast(_Float16, h); }
__device__ __forceinline__ unsigned ordf(float f) { const unsigned u = __float_as_uint(f); return (u & 0x80000000u) ? ~u : (u | 0x80000000u); }


__device__ __forceinline__ void phase_peer(const Ctx& C, int l) {
    const float* MOD = WSP(float, WS_MOD); bf16_t* H = WSP(bf16_t, WS_H); const unsigned short* S = WSP(unsigned short, B_S);
    const bf16_t* TU = WSP(bf16_t, B_TU); const bf16_t* TV = WSP(bf16_t, B_TV);
    const float* g_ = C.a->in[I_LN2G] + l * 1024; const float* b_ = C.a->in[I_LN2B] + l * 1024;
    LAS unsigned* scr = (LAS unsigned*)(C.lds + C.wave * 2048);
    LAS unsigned* skey = scr;
    LAS unsigned* top = scr + 128;
    LAS unsigned* ckey = scr + 160;
    LAS int* sel_e = (LAS int*)(scr + 224);
    LAS float* sel_s = (LAS float*)(scr + 240);
    const int lane = C.lane;
    for (int m = C.bid * 8 + C.wave; m < M_ALL; m += C.nb * 8) {
        float hv[16], out[16];
        { const u32x4* hp = (const u32x4*)(H + (size_t)m * 1024); unpack8(hp[lane], hv); unpack8(hp[64 + lane], hv + 8); }
#pragma unroll
        for (int i = 0; i < 16; ++i) out[i] = 0.f;
        const unsigned short* srow = S + (size_t)m * 2048;
        for (int h = 0; h < 8; ++h) {
#pragma unroll 1
            for (int side = 0; side < 2; ++side) {
                const unsigned short* sp = srow + (h * 2 + side) * 128;
                const unsigned k0 = (ord16(sp[lane]) << 7) | (unsigned)(127 - lane), k1 = (ord16(sp[lane + 64]) << 7) | (unsigned)(63 - lane);
                skey[lane] = k0; skey[lane + 64] = k1; wave_sync();
                int r0 = 0, r1 = 0;
#pragma unroll 8
                for (int y = 0; y < 128; ++y) { const unsigned kk = skey[y]; r0 += kk > k0 ? 1 : 0; r1 += kk > k1 ? 1 : 0; }
                if (r0 < 16) top[side * 16 + r0] = k0;
                if (r1 < 16) top[side * 16 + r1] = k1;
                wave_sync();
            }
            const int pij = PAIR_TAB[lane], pi = pij >> 4, pj = pij & 15;
            const unsigned ka = top[pi], kb = top[16 + pj];
            const float cs = dec16(ka) + dec16(kb);
            const unsigned ck = lane < 50 ? ((ordf(cs) & ~255u) | (unsigned)(255 - pij)) : 0u;
            ckey[lane] = ck; wave_sync();
            int r = 0;
#pragma unroll 8
            for (int y = 0; y < 64; ++y) r += ckey[y] > ck ? 1 : 0;
            if (lane < 50 && r < 16) { sel_e[r] = (int)((127u - (ka & 127u)) * 128u + (127u - (kb & 127u))); sel_s[r] = cs; }
            wave_sync();
            const float sv = sel_s[lane & 15], smax = sel_s[0];
            const float ex = __expf(sv - smax); float den = ex; den += __shfl_xor(den, 1); den += __shfl_xor(den, 2); den += __shfl_xor(den, 4); den += __shfl_xor(den, 8);
            const float gk = ex / den;
            const int ek = sel_e[lane & 15];
#pragma unroll 1
            for (int half = 0; half < 2; ++half) {
                u32x4 ua[8], ub[8], va[8], vb[8];
#pragma unroll
                for (int i = 0; i < 8; ++i) { const int e = __builtin_amdgcn_readlane(ek, half * 8 + i);
                    const u32x4* up = (const u32x4*)(TU + (size_t)e * 1024); const u32x4* vp = (const u32x4*)(TV + (size_t)e * 1024);
                    ua[i] = up[lane]; ub[i] = up[64 + lane]; va[i] = vp[lane]; vb[i] = vp[64 + lane]; }
#pragma unroll
                for (int i = 0; i < 8; ++i) { float t[16]; unpack8(ua[i], t); unpack8(ub[i], t + 8); float p = 0.f;
#pragma unroll
                    for (int j = 0; j < 16; ++j) p += hv[j] * t[j];
                    p = wave_sum(p);
                    const float w = rdlane(gk, half * 8 + i) * gelu_tanh(p);
                    unpack8(va[i], t); unpack8(vb[i], t + 8);
#pragma unroll
                    for (int j = 0; j < 16; ++j) out[j] += w * t[j]; }
            }
            wave_sync();
        }
        const float* xr = xrow_out(C, m); float* xo = xrow_out(C, m);
        const float* md = MOD + (size_t)(l * 9 + mod_index(m)) * 6144;
        float v[16]; float s = 0.f;
#pragma unroll
        for (int hh = 0; hh < 2; ++hh)
#pragma unroll
            for (int q4 = 0; q4 < 2; ++q4) { const int col = hh * 512 + 8 * lane + 4 * q4; const f32x4 x = *(const f32x4*)(xr + col), g2 = *(const f32x4*)(md + 5120 + col);
#pragma unroll
                for (int j = 0; j < 4; ++j) { const float t = ALPHA * x[j] + g2[j] * out[hh * 8 + q4 * 4 + j]; v[hh * 8 + q4 * 4 + j] = t; s += t; } }
        const float mu = wave_sum(s) * (1.f / 1024.f); float q = 0.f;
#pragma unroll
        for (int j = 0; j < 16; ++j) { v[j] -= mu; q += v[j] * v[j]; }
        const float rs = rsqrtf(wave_sum(q) * (1.f / 1024.f) + LN_EPS);
        const float* mdn = MOD + (size_t)((l + 1) * 9 + mod_index(m)) * 6144;
#pragma unroll
        for (int hh = 0; hh < 2; ++hh) { float hn[8];
#pragma unroll
            for (int q4 = 0; q4 < 2; ++q4) { const int col = hh * 512 + 8 * lane + 4 * q4; const f32x4 gg = *(const f32x4*)(g_ + col), bb = *(const f32x4*)(b_ + col); f32x4 x2;
#pragma unroll
                for (int j = 0; j < 4; ++j) x2[j] = v[hh * 8 + q4 * 4 + j] * rs * gg[j] + bb[j];
                *(f32x4*)(xo + col) = x2;
                if (l == 0) { const f32x4 sh = *(const f32x4*)(mdn + col), sc = *(const f32x4*)(mdn + 1024 + col);
#pragma unroll
                    for (int j = 0; j < 4; ++j) hn[q4 * 4 + j] = x2[j] * (1.f + sc[j]) + sh[j]; } }
            if (l == 0) { u32x4 w; w.x = pk2(hn[0], hn[1]); w.y = pk2(hn[2], hn[3]); w.z = pk2(hn[4], hn[5]); w.w = pk2(hn[6], hn[7]); ((u32x4*)(H + (size_t)m * 1024))[hh * 64 + lane] = w; } }
    }
}


constexpr int PG_STRIDE = 272;
__device__ __forceinline__ void ins16(unsigned (&list)[16], unsigned x) {
#pragma unroll
    for (int p = 0; p < 16; ++p) { const unsigned t = max(list[p], x); x = min(list[p], x); list[p] = t; }
}

__device__ __forceinline__ void ce_u32(unsigned& a, unsigned& b, bool desc) { const unsigned hi = max(a, b), lo = min(a, b); a = desc ? hi : lo; b = desc ? lo : hi; }
__device__ __forceinline__ void sort16_desc(unsigned (&a)[16]) {
#pragma unroll
    for (int k = 2; k <= 16; k <<= 1)
#pragma unroll
        for (int j = k >> 1; j >= 1; j >>= 1)
#pragma unroll
            for (int i = 0; i < 16; ++i) { const int l = i ^ j; if (l > i) ce_u32(a[i], a[l], (i & k) == 0); }
}
__device__ __forceinline__ void merge16_desc(unsigned (&top)[16], const unsigned (&nw)[16]) {
#pragma unroll
    for (int i = 0; i < 16; ++i) top[i] = max(top[i], nw[15 - i]);
#pragma unroll
    for (int j = 8; j >= 1; j >>= 1)
#pragma unroll
        for (int i = 0; i < 16; ++i) { const int l = i ^ j; if (l > i) ce_u32(top[i], top[l], true); }
}
__device__ __forceinline__ unsigned key_h(unsigned h, int idx) { const unsigned m = (unsigned)((int)(h << 16) >> 31); const unsigned o = (h ^ ((m & 0x7fffu) | 0x8000u)) & 0xffffu; return (o << 7) | (unsigned)(127 - idx); }
__device__ __forceinline__ float reduce8(const float (&p)[8], int lane) {
    float q[4], r[2];
#pragma unroll
    for (int i = 0; i < 4; ++i) { const bool hi = lane & 32; const float send = hi ? p[i] : p[4 + i], keep = hi ? p[4 + i] : p[i]; q[i] = keep + __shfl_xor(send, 32); }
#pragma unroll
    for (int i = 0; i < 2; ++i) { const bool hi = lane & 16; const float send = hi ? q[i] : q[2 + i], keep = hi ? q[2 + i] : q[i]; r[i] = keep + __shfl_xor(send, 16); }
    float t; { const bool hi = lane & 8; const float send = hi ? r[0] : r[1], keep = hi ? r[1] : r[0]; t = keep + __shfl_xor(send, 8); }
    t += __shfl_xor(t, 4); t += __shfl_xor(t, 2); t += __shfl_xor(t, 1);
    return t;
}
__device__ __forceinline__ void peer_token(const Ctx& C, int l, int m, int tl) {
    const float* MOD = WSP(float, WS_MOD); bf16_t* H = WSP(bf16_t, WS_H);
    const bf16_t* TU = WSP(bf16_t, B_TU); const bf16_t* TV = WSP(bf16_t, B_TV);
    const float* g_ = C.a->in[I_LN2G] + l * 1024; const float* b_ = C.a->in[I_LN2B] + l * 1024;
    const int lane = C.lane;
    float hv[16], out[16];
    { const u32x4* hp = (const u32x4*)(H + (size_t)m * 1024); unpack8(hp[lane], hv); unpack8(hp[64 + lane], hv + 8); }
#pragma unroll
    for (int i = 0; i < 16; ++i) out[i] = 0.f;
#pragma unroll 1
    for (int h = 0; h < 8; ++h) {
        const LAS unsigned char* rA = C.lds + (tl * 16 + 2 * h) * PG_STRIDE;
        const int ek = *(const LAS int*)(rA + 4 * (lane & 15)); const float gk = *(const LAS float*)(rA + PG_STRIDE + 4 * (lane & 15));
#pragma unroll 1
        for (int half = 0; half < 2; ++half) {
            u32x4 ua[8], ub[8], va[8], vb[8];
#pragma unroll
            for (int i = 0; i < 8; ++i) { const int e = __builtin_amdgcn_readlane(ek, half * 8 + i);
                const u32x4* up = (const u32x4*)(TU + (size_t)e * 1024); const u32x4* vp = (const u32x4*)(TV + (size_t)e * 1024);
                ua[i] = up[lane]; ub[i] = up[64 + lane]; va[i] = vp[lane]; vb[i] = vp[64 + lane]; }
            float p[8];
#pragma unroll
            for (int i = 0; i < 8; ++i) { float t[16]; unpack8(ua[i], t); unpack8(ub[i], t + 8); float a = 0.f;
#pragma unroll
                for (int j = 0; j < 16; ++j) a += hv[j] * t[j];
                p[i] = a; }
            const float tsum = reduce8(p, lane);
#pragma unroll
            for (int i = 0; i < 8; ++i) { const float dot = rdlane(tsum, (i >> 2) * 32 + ((i >> 1) & 1) * 16 + (i & 1) * 8);
                const float w = rdlane(gk, half * 8 + i) * gelu_tanh(dot);
                float t[16]; unpack8(va[i], t); unpack8(vb[i], t + 8);
#pragma unroll
                for (int j = 0; j < 16; ++j) out[j] += w * t[j]; }
        }
    }
    float* xo = xrow_out(C, m); const float* xr = xo;
    const float* md = MOD + (size_t)(l * 9 + mod_index(m)) * 6144;
    float v[16]; float s = 0.f;
#pragma unroll
    for (int hh = 0; hh < 2; ++hh)
#pragma unroll
        for (int q4 = 0; q4 < 2; ++q4) { const int col = hh * 512 + 8 * lane + 4 * q4; const f32x4 x = *(const f32x4*)(xr + col), g2 = *(const f32x4*)(md + 5120 + col);
#pragma unroll
            for (int j = 0; j < 4; ++j) { const float t = ALPHA * x[j] + g2[j] * out[hh * 8 + q4 * 4 + j]; v[hh * 8 + q4 * 4 + j] = t; s += t; } }
    const float mu = wave_sum(s) * (1.f / 1024.f); float q = 0.f;
#pragma unroll
    for (int j = 0; j < 16; ++j) { v[j] -= mu; q += v[j] * v[j]; }
    const float rs = rsqrtf(wave_sum(q) * (1.f / 1024.f) + LN_EPS);
    const float* mdn = MOD + (size_t)((l + 1) * 9 + mod_index(m)) * 6144;
#pragma unroll
    for (int hh = 0; hh < 2; ++hh) { float hn[8];
#pragma unroll
        for (int q4 = 0; q4 < 2; ++q4) { const int col = hh * 512 + 8 * lane + 4 * q4; const f32x4 gg = *(const f32x4*)(g_ + col), bb = *(const f32x4*)(b_ + col); f32x4 x2;
#pragma unroll
            for (int j = 0; j < 4; ++j) x2[j] = v[hh * 8 + q4 * 4 + j] * rs * gg[j] + bb[j];
            *(f32x4*)(xo + col) = x2;
            if (l == 0) { const f32x4 sh = *(const f32x4*)(mdn + col), sc = *(const f32x4*)(mdn + 1024 + col);
#pragma unroll
                for (int j = 0; j < 4; ++j) hn[q4 * 4 + j] = x2[j] * (1.f + sc[j]) + sh[j]; } }
        if (l == 0) { u32x4 w; w.x = pk2(hn[0], hn[1]); w.y = pk2(hn[2], hn[3]); w.z = pk2(hn[4], hn[5]); w.w = pk2(hn[6], hn[7]); ((u32x4*)(H + (size_t)m * 1024))[hh * 64 + lane] = w; } }
}

constexpr float TU_SCALE = 256.f, TV_SCALE = 16.f;
__device__ __forceinline__ void phase_tables8(const Ctx& C, int l) {
    const f32x4* su = (const f32x4*)(C.a->in[I_PU] + (size_t)l * 16384 * 1024); const f32x4* sv = (const f32x4*)(C.a->in[I_PV] + (size_t)l * 16384 * 1024);
    u32x4* du = WSP(u32x4, B_TU); u32x4* dv = WSP(u32x4, B_TV);
    const long n16 = (long)16384 * 1024 / 16;
    for (long i = (long)C.bid * NT + C.tid; i < n16; i += (long)C.nb * NT) {
        u32x4 wa, wb;
#pragma unroll
        for (int k = 0; k < 4; ++k) { const f32x4 a = su[4 * i + k] * TU_SCALE, b = sv[4 * i + k] * TV_SCALE; unsigned x = 0u, y = 0u;
            x = __builtin_amdgcn_cvt_pk_fp8_f32(a[0], a[1], x, false); x = __builtin_amdgcn_cvt_pk_fp8_f32(a[2], a[3], x, true);
            y = __builtin_amdgcn_cvt_pk_fp8_f32(b[0], b[1], y, false); y = __builtin_amdgcn_cvt_pk_fp8_f32(b[2], b[3], y, true);
            wa[k] = x; wb[k] = y; }
        du[i] = wa; dv[i] = wb; }
}
__device__ __forceinline__ void unpack16_fp8(const u32x4 v, float* o) {
#pragma unroll
    for (int k = 0; k < 4; ++k) { const f32x2 lo = __builtin_amdgcn_cvt_pk_f32_fp8((int)v[k], false), hi = __builtin_amdgcn_cvt_pk_f32_fp8((int)v[k], true); o[4 * k] = lo.x; o[4 * k + 1] = lo.y; o[4 * k + 2] = hi.x; o[4 * k + 3] = hi.y; }
}
__device__ __forceinline__ void peer_token8(const Ctx& C, int l, int m, int tl, bool dry) {
    const float* MOD = WSP(float, WS_MOD); bf16_t* H = WSP(bf16_t, WS_H);
    const unsigned char* TU = WSP(unsigned char, B_TU); const unsigned char* TV = WSP(unsigned char, B_TV);
    const float* g_ = C.a->in[I_LN2G] + l * 1024; const float* b_ = C.a->in[I_LN2B] + l * 1024;
    const int lane = C.lane;
    float hv[16], out[16];
    { const u32x4* hp = (const u32x4*)(H + (size_t)m * 1024); unpack8(hp[2 * lane], hv); unpack8(hp[2 * lane + 1], hv + 8); }
#pragma unroll
    for (int i = 0; i < 16; ++i) out[i] = 0.f;
#pragma unroll 1
    for (int h = 0; h < 8; ++h) {
        const LAS unsigned char* rA = C.lds + (tl * 16 + 2 * h) * PG_STRIDE;
        const int ek = *(const LAS int*)(rA + 4 * (lane & 15)); const float gk = *(const LAS float*)(rA + PG_STRIDE + 4 * (lane & 15));
#pragma unroll 1
        for (int half = 0; half < 2; ++half) {
            u32x4 ur[8], vr[8];
#pragma unroll
            for (int i = 0; i < 8; ++i) { const int e = __builtin_amdgcn_readlane(ek, half * 8 + i); ur[i] = ((const u32x4*)(TU + (size_t)e * 1024))[lane]; vr[i] = ((const u32x4*)(TV + (size_t)e * 1024))[lane]; }
            __builtin_amdgcn_sched_barrier(0);
            float p[8];
#pragma unroll
            for (int i = 0; i < 8; ++i) { float t[16]; unpack16_fp8(ur[i], t); float a = 0.f;
#pragma unroll
                for (int j = 0; j < 16; ++j) a += hv[j] * t[j];
                p[i] = a; __builtin_amdgcn_sched_barrier(0); }
            const float tsum = reduce8(p, lane);
#pragma unroll
            for (int i = 0; i < 8; ++i) { const float dot = rdlane(tsum, (i >> 2) * 32 + ((i >> 1) & 1) * 16 + (i & 1) * 8) * (1.f / TU_SCALE);
                const float w = rdlane(gk, half * 8 + i) * gelu_tanh(dot) * (1.f / TV_SCALE);
                float t[16]; unpack16_fp8(vr[i], t);
#pragma unroll
                for (int j = 0; j < 16; ++j) out[j] += w * t[j];
                __builtin_amdgcn_sched_barrier(0); }
        }
    }
    float* xo = xrow_out(C, m); float* xw = dry ? WSP(float, B_VN) + (size_t)(C.bid * 8 + C.wave) * 1024 : xo; bf16_t* hw = dry ? WSP(bf16_t, B_VN + 16 * MiB) + (size_t)(C.bid * 8 + C.wave) * 1024 : H + (size_t)m * 1024;
    const float* md = MOD + (size_t)(l * 9 + mod_index(m)) * 6144;
    float v[16]; float s = 0.f;
#pragma unroll
    for (int q4 = 0; q4 < 4; ++q4) { const int col = 16 * lane + 4 * q4; const f32x4 x = *(const f32x4*)(xo + col), g2 = *(const f32x4*)(md + 5120 + col);
#pragma unroll
        for (int j = 0; j < 4; ++j) { const float t = ALPHA * x[j] + g2[j] * out[q4 * 4 + j]; v[q4 * 4 + j] = t; s += t; } }
    const float mu = wave_sum(s) * (1.f / 1024.f); float q = 0.f;
#pragma unroll
    for (int j = 0; j < 16; ++j) { v[j] -= mu; q += v[j] * v[j]; }
    const float rs = rsqrtf(wave_sum(q) * (1.f / 1024.f) + LN_EPS);
    const float* mdn = MOD + (size_t)((l + 1) * 9 + mod_index(m)) * 6144;
    float hn[16];
#pragma unroll
    for (int q4 = 0; q4 < 4; ++q4) { const int col = 16 * lane + 4 * q4; const f32x4 gg = *(const f32x4*)(g_ + col), bb = *(const f32x4*)(b_ + col); f32x4 x2;
#pragma unroll
        for (int j = 0; j < 4; ++j) x2[j] = v[q4 * 4 + j] * rs * gg[j] + bb[j];
        *(f32x4*)(xw + col) = x2;
        if (l == 0) { const f32x4 sh = *(const f32x4*)(mdn + col), sc = *(const f32x4*)(mdn + 1024 + col);
#pragma unroll
            for (int j = 0; j < 4; ++j) hn[q4 * 4 + j] = x2[j] * (1.f + sc[j]) + sh[j]; } }
    if (l == 0) { u32x4 w0, w1; w0.x = pk2(hn[0], hn[1]); w0.y = pk2(hn[2], hn[3]); w0.z = pk2(hn[4], hn[5]); w0.w = pk2(hn[6], hn[7]);
        w1.x = pk2(hn[8], hn[9]); w1.y = pk2(hn[10], hn[11]); w1.z = pk2(hn[12], hn[13]); w1.w = pk2(hn[14], hn[15]);
        u32x4* hp = (u32x4*)hw; hp[2 * lane] = w0; hp[2 * lane + 1] = w1; }
}


typedef float v32f __attribute__((ext_vector_type(32)));
typedef float v16f __attribute__((ext_vector_type(16)));
typedef int v6i __attribute__((ext_vector_type(6)));
constexpr float T6U = 48.f, T6V = 3.f;

__device__ __forceinline__ unsigned fp6_enc(float a) {
    const unsigned sg = (__float_as_uint(a) >> 31) << 5; const float m = fminf(fabsf(a), 7.5f);
    unsigned code;
    if (m < 1.f) code = (unsigned)rintf(m * 8.f);
    else { const int e = (m >= 4.f) ? 3 : ((m >= 2.f) ? 2 : 1); const float inv = (e == 3) ? 2.f : ((e == 2) ? 4.f : 8.f); code = (unsigned)((e - 1) * 8) + (unsigned)rintf(m * inv); }
    code = min(code, 31u);
    return sg | code;
}
__device__ __forceinline__ void fp6_pack16(const float* x, float scale, unsigned (&d)[3]) {
    unsigned long long lo = 0ull; unsigned hi = 0u;
#pragma unroll
    for (int k = 0; k < 16; ++k) { const unsigned long long f = fp6_enc(x[k] * scale); const int bit = 6 * k;
        if (bit < 64) { lo |= f << bit; if (bit > 58) hi |= (unsigned)(f >> (64 - bit)); } else hi |= (unsigned)f << (bit - 64); }
    d[0] = (unsigned)lo; d[1] = (unsigned)(lo >> 32); d[2] = hi;
}
__device__ __forceinline__ void phase_tables6(const Ctx& C, int l) {
    const float* su = C.a->in[I_PU] + (size_t)l * 16384 * 1024; const float* sv = C.a->in[I_PV] + (size_t)l * 16384 * 1024;
    unsigned char* T = WSP(unsigned char, B_TU);
    const long n = (long)16384 * 64;
    for (long i = (long)C.bid * NT + C.tid; i < n; i += (long)C.nb * NT) {
        const long e = i >> 6; const int ln = (int)(i & 63);
        float x[16], y[16];
#pragma unroll
        for (int k = 0; k < 4; ++k) { const f32x4 a = *(const f32x4*)(su + e * 1024 + 16 * ln + 4 * k), b = *(const f32x4*)(sv + e * 1024 + 16 * ln + 4 * k);
#pragma unroll
            for (int j = 0; j < 4; ++j) { x[4 * k + j] = a[j]; y[4 * k + j] = b[j]; } }
        unsigned du[3], dv[3]; fp6_pack16(x, T6U, du); fp6_pack16(y, T6V, dv);
        unsigned char* pu = T + e * 768; unsigned char* pv = WSP(unsigned char, B_TV) + e * 768;
        u32x2 w0, w1; w0.x = du[0]; w0.y = du[1]; w1.x = dv[0]; w1.y = dv[1];
        *(u32x2*)(pu + ln * 8) = w0; *(unsigned*)(pu + 512 + ln * 4) = du[2]; *(u32x2*)(pv + ln * 8) = w1; *(unsigned*)(pv + 512 + ln * 4) = dv[2]; }
}
__device__ __forceinline__ bool fp6_roundtrip_ok() {
    float x[16], y[16];
#pragma unroll
    for (int j = 0; j < 16; ++j) { x[j] = (j & 8) ? -(1.f + 0.125f * (float)(j & 7)) : 0.125f * (float)(j & 7); y[j] = ((j & 1) ? -1.f : 1.f) * ((j < 8) ? (2.f + 0.25f * (float)j) : (4.f + 0.5f * (float)(j - 8))); }
    unsigned du[3], dv[3]; fp6_pack16(x, 1.f, du); fp6_pack16(y, 1.f, dv);
    v6i w; w[0] = (int)du[0]; w[1] = (int)du[1]; w[2] = (int)du[2]; w[3] = (int)dv[0]; w[4] = (int)dv[1]; w[5] = (int)dv[2];
    const v32f r = __builtin_amdgcn_cvt_scalef32_pk32_f32_fp6(w, 1.0f);
    bool ok = true;
#pragma unroll
    for (int j = 0; j < 16; ++j) ok = ok && (r[j] == x[j]) && (r[16 + j] == y[j]);
    return ok;
}

#define PFMA(acc, x, y) asm("v_fmac_f32 %0, %1, %2" : "+v"(acc) : "v"(x), "v"(y))
__device__ __forceinline__ float gelu_fast(float x) { const float y = 0.7978845608028654f * (x + 0.044715f * x * x * x); const float t = 1.f - 2.f * __builtin_amdgcn_rcpf(__expf(2.f * y) + 1.f); return 0.5f * x * (1.f + t); }

__device__ __forceinline__ void peer_sort_token(const Ctx& C, int tl) {
    const int lane = C.lane; const LAS unsigned char* rb = C.lds + (tl * 16) * PG_STRIDE;
    const int i0 = lane, i1 = lane + 64;
    const int e0 = *(const LAS int*)(rb + (2 * (i0 >> 4)) * PG_STRIDE + 4 * (i0 & 15)), e1 = *(const LAS int*)(rb + (2 * (i1 >> 4)) * PG_STRIDE + 4 * (i1 & 15));
    const unsigned g0 = *(const LAS unsigned*)(rb + (2 * (i0 >> 4) + 1) * PG_STRIDE + 4 * (i0 & 15)), g1 = *(const LAS unsigned*)(rb + (2 * (i1 >> 4) + 1) * PG_STRIDE + 4 * (i1 & 15));
    const int r0 = e0 >> 10, r1 = e1 >> 10; int base = 0, pos0 = 0, pos1 = 0;
#pragma unroll
    for (int r = 0; r < 16; ++r) { const unsigned long long b0 = __ballot(r0 == r), b1 = __ballot(r1 == r); const int c0 = __popcll(b0);
        const int m0 = (int)__builtin_amdgcn_mbcnt_hi((unsigned)(b0 >> 32), __builtin_amdgcn_mbcnt_lo((unsigned)b0, 0u)), m1 = (int)__builtin_amdgcn_mbcnt_hi((unsigned)(b1 >> 32), __builtin_amdgcn_mbcnt_lo((unsigned)b1, 0u));
        if (r0 == r) pos0 = base + m0;
        if (r1 == r) pos1 = base + c0 + m1;
        base += c0 + __popcll(b1); }
    u32x2 w0, w1; w0.x = (unsigned)e0; w0.y = g0; w1.x = (unsigned)e1; w1.y = g1;
    *(LAS u32x2*)(C.lds + (tl * 16 + (pos0 >> 4)) * PG_STRIDE + 64 + 8 * (pos0 & 15)) = w0;
    *(LAS u32x2*)(C.lds + (tl * 16 + (pos1 >> 4)) * PG_STRIDE + 64 + 8 * (pos1 & 15)) = w1;
}
typedef _Float16 v32h __attribute__((ext_vector_type(32)));
typedef _Float16 h2v __attribute__((ext_vector_type(2)));
__device__ __forceinline__ void peer_token6(const Ctx& C, int l, int m, int tl, bool dry) {
    const float* MOD = WSP(float, WS_MOD); bf16_t* H = WSP(bf16_t, WS_H);
    const unsigned char* TU6 = WSP(unsigned char, B_TU); const unsigned char* TV6 = WSP(unsigned char, B_TV);
    const float* g_ = C.a->in[I_LN2G] + l * 1024; const float* b_ = C.a->in[I_LN2B] + l * 1024;
    const int lane = C.lane;
    const unsigned lo8 = (unsigned)lane * 8u, lo4 = (unsigned)lane * 4u;
    const __amdgpu_buffer_rsrc_t rsU = __builtin_amdgcn_make_buffer_rsrc((void*)TU6, (short)0, 16384 * 768, 0x00020000), rsV = __builtin_amdgcn_make_buffer_rsrc((void*)TV6, (short)0, 16384 * 768, 0x00020000);
    float out[16]; h2v hh[8], oh[8];
    { float hv[16]; const u32x4* hp = (const u32x4*)(H + (size_t)m * 1024); unpack8(hp[2 * lane], hv); unpack8(hp[2 * lane + 1], hv + 8);
#pragma unroll
      for (int j = 0; j < 8; ++j) { hh[j][0] = (_Float16)hv[2 * j]; hh[j][1] = (_Float16)hv[2 * j + 1]; } }
#pragma unroll
    for (int i = 0; i < 16; ++i) out[i] = 0.f;
#pragma unroll
    for (int j = 0; j < 8; ++j) oh[j] = (h2v){(_Float16)0.f, (_Float16)0.f};
#pragma unroll 1
    for (int bi = 0; bi < 16; ++bi) {
        {
            const int idx_ = 8 * bi + (lane & 7); const u32x2 ent_ = *(const LAS u32x2*)(C.lds + (tl * 16 + (idx_ >> 4)) * PG_STRIDE + 64 + 8 * (idx_ & 15));
            const int ek = (int)ent_.x; const float gk = __uint_as_float(ent_.y); constexpr int half = 0;
            u32x2 ua[8], va[8]; unsigned ub[8], vb[8];
#pragma unroll
            for (int i = 0; i < 8; ++i) { const unsigned eo = __builtin_amdgcn_readfirstlane((unsigned)__builtin_amdgcn_readlane(ek, half * 8 + i) * 768u);
                ua[i] = __builtin_bit_cast(u32x2, __builtin_amdgcn_raw_buffer_load_b64(rsU, lo8, eo, 0)); ub[i] = __builtin_amdgcn_raw_buffer_load_b32(rsU, 512u + lo4, eo, 0);
                va[i] = __builtin_bit_cast(u32x2, __builtin_amdgcn_raw_buffer_load_b64(rsV, lo8, eo, 0)); vb[i] = __builtin_amdgcn_raw_buffer_load_b32(rsV, 512u + lo4, eo, 0); }
            __builtin_amdgcn_sched_barrier(0);
            float p[8];
#pragma unroll
            for (int i = 0; i < 8; i += 2) { v6i w; w[0] = (int)ua[i].x; w[1] = (int)ua[i].y; w[2] = (int)ub[i]; w[3] = (int)ua[i + 1].x; w[4] = (int)ua[i + 1].y; w[5] = (int)ub[i + 1];
                const v32h t = __builtin_amdgcn_cvt_scalef32_pk32_f16_fp6(w, 1.0f); h2v a = (h2v){(_Float16)0.f, (_Float16)0.f}, b = a;
#pragma unroll
                for (int j = 0; j < 8; ++j) { a = __builtin_elementwise_fma(hh[j], (h2v){t[2 * j], t[2 * j + 1]}, a); b = __builtin_elementwise_fma(hh[j], (h2v){t[16 + 2 * j], t[17 + 2 * j]}, b); }
                p[i] = (float)a[0] + (float)a[1]; p[i + 1] = (float)b[0] + (float)b[1]; __builtin_amdgcn_sched_barrier(0); }
            const float tsum = reduce8(p, lane);
            const int myx = ((lane >> 5) & 1) * 4 + ((lane >> 4) & 1) * 2 + ((lane >> 3) & 1);
            const float wl = __shfl(gk, half * 8 + myx) * gelu_fast(tsum * (1.f / T6U)) * (1.f / T6V);
            const h2v wl2 = (h2v){(_Float16)wl, (_Float16)wl};
            const int wlb = __builtin_bit_cast(int, wl2);
#pragma unroll
            for (int i = 0; i < 8; i += 2) {
                const h2v w0 = __builtin_bit_cast(h2v, __builtin_amdgcn_readlane(wlb, (i >> 2) * 32 + ((i >> 1) & 1) * 16 + (i & 1) * 8)), w1 = __builtin_bit_cast(h2v, __builtin_amdgcn_readlane(wlb, ((i + 1) >> 2) * 32 + (((i + 1) >> 1) & 1) * 16 + ((i + 1) & 1) * 8));
                v6i w; w[0] = (int)va[i].x; w[1] = (int)va[i].y; w[2] = (int)vb[i]; w[3] = (int)va[i + 1].x; w[4] = (int)va[i + 1].y; w[5] = (int)vb[i + 1];
                const v32h t = __builtin_amdgcn_cvt_scalef32_pk32_f16_fp6(w, 1.0f);
#pragma unroll
                for (int j = 0; j < 8; ++j) oh[j] = __builtin_elementwise_fma(w0, (h2v){t[2 * j], t[2 * j + 1]}, oh[j]);
#pragma unroll
                for (int j = 0; j < 8; ++j) oh[j] = __builtin_elementwise_fma(w1, (h2v){t[16 + 2 * j], t[17 + 2 * j]}, oh[j]);
                __builtin_amdgcn_sched_barrier(0); }
        }
        if ((bi & 3) == 3) {
#pragma unroll
            for (int j = 0; j < 8; ++j) { out[2 * j] += (float)oh[j][0]; out[2 * j + 1] += (float)oh[j][1]; oh[j] = (h2v){(_Float16)0.f, (_Float16)0.f}; } }
    }
    float* xo = xrow_out(C, m); float* xw = dry ? WSP(float, B_VN) + (size_t)(C.bid * 8 + C.wave) * 1024 : xo; bf16_t* hw = dry ? WSP(bf16_t, B_VN + 16 * MiB) + (size_t)(C.bid * 8 + C.wave) * 1024 : H + (size_t)m * 1024;
    const float* md = MOD + (size_t)(l * 9 + mod_index(m)) * 6144;
    float v[16]; float s = 0.f;
#pragma unroll
    for (int q4 = 0; q4 < 4; ++q4) { const int col = 16 * lane + 4 * q4; const f32x4 x = *(const f32x4*)(xo + col), g2 = *(const f32x4*)(md + 5120 + col);
#pragma unroll
        for (int j = 0; j < 4; ++j) { const float t = ALPHA * x[j] + g2[j] * out[q4 * 4 + j]; v[q4 * 4 + j] = t; s += t; } }
    const float mu = wave_sum(s) * (1.f / 1024.f); float q = 0.f;
#pragma unroll
    for (int j = 0; j < 16; ++j) { v[j] -= mu; q += v[j] * v[j]; }
    const float rs = rsqrtf(wave_sum(q) * (1.f / 1024.f) + LN_EPS);
    const float* mdn = MOD + (size_t)((l + 1) * 9 + mod_index(m)) * 6144;
    float hn[16];
#pragma unroll
    for (int q4 = 0; q4 < 4; ++q4) { const int col = 16 * lane + 4 * q4; const f32x4 gg = *(const f32x4*)(g_ + col), bb = *(const f32x4*)(b_ + col); f32x4 x2;
#pragma unroll
        for (int j = 0; j < 4; ++j) x2[j] = v[q4 * 4 + j] * rs * gg[j] + bb[j];
        *(f32x4*)(xw + col) = x2;
        if (l == 0) { const f32x4 sh = *(const f32x4*)(mdn + col), sc = *(const f32x4*)(mdn + 1024 + col);
#pragma unroll
            for (int j = 0; j < 4; ++j) hn[q4 * 4 + j] = x2[j] * (1.f + sc[j]) + sh[j]; } }
    if (l == 0) { u32x4 w0, w1; w0.x = pk2(hn[0], hn[1]); w0.y = pk2(hn[2], hn[3]); w0.z = pk2(hn[4], hn[5]); w0.w = pk2(hn[6], hn[7]);
        w1.x = pk2(hn[8], hn[9]); w1.y = pk2(hn[10], hn[11]); w1.z = pk2(hn[12], hn[13]); w1.w = pk2(hn[14], hn[15]);
        u32x4* hp = (u32x4*)hw; hp[2 * lane] = w0; hp[2 * lane + 1] = w1; }
}

__device__ __forceinline__ void peer_ln2(const Ctx& C, int l, int m, const h2v (&oh)[8], const f32x4 (&xin)[4], bool dry) {
    const float* MOD = WSP(float, WS_MOD); bf16_t* H = WSP(bf16_t, WS_H);
    const float* g_ = C.a->in[I_LN2G] + l * 1024; const float* b_ = C.a->in[I_LN2B] + l * 1024;
    const int lane = C.lane;
    float out[16];
#pragma unroll
    for (int j = 0; j < 8; ++j) { out[2 * j] = (float)oh[j][0]; out[2 * j + 1] = (float)oh[j][1]; }
    float* xo = xrow_out(C, m); float* xw = dry ? WSP(float, B_VN) + (size_t)(C.bid * 8 + C.wave) * 1024 : xo; bf16_t* hw = dry ? WSP(bf16_t, B_VN + 16 * MiB) + (size_t)(C.bid * 8 + C.wave) * 1024 : H + (size_t)m * 1024;
    const float* md = MOD + (size_t)(l * 9 + mod_index(m)) * 6144;
    float v[16]; float s = 0.f;
#pragma unroll
    for (int q4 = 0; q4 < 4; ++q4) { const int col = 16 * lane + 4 * q4; const f32x4 x = xin[q4], g2 = *(const f32x4*)(md + 5120 + col);
#pragma unroll
        for (int j = 0; j < 4; ++j) { const float t = ALPHA * x[j] + g2[j] * out[q4 * 4 + j]; v[q4 * 4 + j] = t; s += t; } }
    const float mu = wave_sum(s) * (1.f / 1024.f); float q = 0.f;
#pragma unroll
    for (int j = 0; j < 16; ++j) { v[j] -= mu; q += v[j] * v[j]; }
    const float rs = rsqrtf(wave_sum(q) * (1.f / 1024.f) + LN_EPS);
    const float* mdn = MOD + (size_t)((l + 1) * 9 + mod_index(m)) * 6144;
    float hn[16];
#pragma unroll
    for (int q4 = 0; q4 < 4; ++q4) { const int col = 16 * lane + 4 * q4; const f32x4 gg = *(const f32x4*)(g_ + col), bb = *(const f32x4*)(b_ + col); f32x4 x2;
#pragma unroll
        for (int j = 0; j < 4; ++j) x2[j] = v[q4 * 4 + j] * rs * gg[j] + bb[j];
        *(f32x4*)(xw + col) = x2;
        if (l == 0) { const f32x4 sh = *(const f32x4*)(mdn + col), sc = *(const f32x4*)(mdn + 1024 + col);
#pragma unroll
            for (int j = 0; j < 4; ++j) hn[q4 * 4 + j] = x2[j] * (1.f + sc[j]) + sh[j]; } }
    if (l == 0) { u32x4 w0, w1; w0.x = pk2(hn[0], hn[1]); w0.y = pk2(hn[2], hn[3]); w0.z = pk2(hn[4], hn[5]); w0.w = pk2(hn[6], hn[7]);
        w1.x = pk2(hn[8], hn[9]); w1.y = pk2(hn[10], hn[11]); w1.z = pk2(hn[12], hn[13]); w1.w = pk2(hn[14], hn[15]);
        u32x4* hp = (u32x4*)hw; hp[2 * lane] = w0; hp[2 * lane + 1] = w1; }
}
__device__ __forceinline__ void peer_batch(int ek, float gk, const h2v (&hh)[8], h2v (&oh)[8], const __amdgpu_buffer_rsrc_t rsU, const __amdgpu_buffer_rsrc_t rsV, unsigned lo8, unsigned lo4, int lane) {
    u32x2 ua[8], va[8]; unsigned ub[8], vb[8];
#pragma unroll
    for (int i = 0; i < 8; ++i) { const unsigned eo = __builtin_amdgcn_readfirstlane((unsigned)__builtin_amdgcn_readlane(ek, i) * 768u);
        ua[i] = __builtin_bit_cast(u32x2, __builtin_amdgcn_raw_buffer_load_b64(rsU, lo8, eo, 0)); ub[i] = __builtin_amdgcn_raw_buffer_load_b32(rsU, 512u + lo4, eo, 0);
        va[i] = __builtin_bit_cast(u32x2, __builtin_amdgcn_raw_buffer_load_b64(rsV, lo8, eo, 0)); vb[i] = __builtin_amdgcn_raw_buffer_load_b32(rsV, 512u + lo4, eo, 0); }
    __builtin_amdgcn_sched_barrier(0);
    float p[8];
#pragma unroll
    for (int i = 0; i < 8; i += 2) { v6i w; w[0] = (int)ua[i].x; w[1] = (int)ua[i].y; w[2] = (int)ub[i]; w[3] = (int)ua[i + 1].x; w[4] = (int)ua[i + 1].y; w[5] = (int)ub[i + 1];
        const v32h t = __builtin_amdgcn_cvt_scalef32_pk32_f16_fp6(w, 1.0f); float a = 0.f, b = 0.f;
#pragma unroll
        for (int j = 0; j < 8; ++j) { a = __builtin_amdgcn_fdot2(hh[j], (h2v){t[2 * j], t[2 * j + 1]}, a, false); b = __builtin_amdgcn_fdot2(hh[j], (h2v){t[16 + 2 * j], t[17 + 2 * j]}, b, false); }
        p[i] = a; p[i + 1] = b; }
    const float tsum = reduce8(p, lane);
    const int myx = ((lane >> 5) & 1) * 4 + ((lane >> 4) & 1) * 2 + ((lane >> 3) & 1);
    const float wl = __shfl(gk, myx) * gelu_fast(tsum * (1.f / T6U)) * (1.f / T6V);
    const int wlb = __builtin_bit_cast(int, (h2v){(_Float16)wl, (_Float16)wl});
#pragma unroll
    for (int i = 0; i < 8; i += 2) {
        const h2v w0 = __builtin_bit_cast(h2v, __builtin_amdgcn_readlane(wlb, (i >> 2) * 32 + ((i >> 1) & 1) * 16 + (i & 1) * 8)), w1 = __builtin_bit_cast(h2v, __builtin_amdgcn_readlane(wlb, ((i + 1) >> 2) * 32 + (((i + 1) >> 1) & 1) * 16 + ((i + 1) & 1) * 8));
        v6i w; w[0] = (int)va[i].x; w[1] = (int)va[i].y; w[2] = (int)vb[i]; w[3] = (int)va[i + 1].x; w[4] = (int)va[i + 1].y; w[5] = (int)vb[i + 1];
        const v32h t = __builtin_amdgcn_cvt_scalef32_pk32_f16_fp6(w, 1.0f);
#pragma unroll
        for (int j = 0; j < 8; ++j) oh[j] = __builtin_elementwise_fma(w0, (h2v){t[2 * j], t[2 * j + 1]}, oh[j]);
#pragma unroll
        for (int j = 0; j < 8; ++j) oh[j] = __builtin_elementwise_fma(w1, (h2v){t[16 + 2 * j], t[17 + 2 * j]}, oh[j]);
        }
}

__device__ __forceinline__ void peer_tokens4(const Ctx& C, int l, int t0, int nt, bool dry) {
    bf16_t* H = WSP(bf16_t, WS_H);
    const unsigned char* TU6 = WSP(unsigned char, B_TU); const unsigned char* TV6 = WSP(unsigned char, B_TV);
    const int lane = C.lane; const unsigned lo8 = (unsigned)lane * 8u, lo4 = (unsigned)lane * 4u;
    const __amdgpu_buffer_rsrc_t rsU = __builtin_amdgcn_make_buffer_rsrc((void*)TU6, (short)0, 16384 * 768, 0x00020000), rsV = __builtin_amdgcn_make_buffer_rsrc((void*)TV6, (short)0, 16384 * 768, 0x00020000);
    h2v hh[4][8], oh[4][8];
#pragma unroll
    for (int k = 0; k < 4; ++k) { const int tl = C.wave + 8 * k;
#pragma unroll
        for (int j = 0; j < 8; ++j) { hh[k][j] = (h2v){(_Float16)0.f, (_Float16)0.f}; oh[k][j] = hh[k][j]; }
        if (tl < nt) { float hv[16]; const u32x4* hp = (const u32x4*)(H + (size_t)(t0 + tl) * 1024); unpack8(hp[2 * lane], hv); unpack8(hp[2 * lane + 1], hv + 8);
#pragma unroll
            for (int j = 0; j < 8; ++j) { hh[k][j][0] = (_Float16)hv[2 * j]; hh[k][j][1] = (_Float16)hv[2 * j + 1]; } } }
#pragma unroll 1
    for (int bi = 0; bi < 16; ++bi) {
#pragma unroll
        for (int k = 0; k < 4; ++k) { const int tl = C.wave + 8 * k;
            if (tl < nt) { const int idx = 8 * bi + (lane & 7); const u32x2 ent = *(const LAS u32x2*)(C.lds + (tl * 16 + (idx >> 4)) * PG_STRIDE + 64 + 8 * (idx & 15));
                peer_batch((int)ent.x, __uint_as_float(ent.y), hh[k], oh[k], rsU, rsV, lo8, lo4, lane); } } }
    f32x4 xr[4][4];
#pragma unroll
    for (int k = 0; k < 4; ++k) { const int tl = C.wave + 8 * k;
#pragma unroll
        for (int q4 = 0; q4 < 4; ++q4) xr[k][q4] = (f32x4){0.f, 0.f, 0.f, 0.f};
        if (tl < nt) { const float* xo = xrow_out(C, t0 + tl);
#pragma unroll
            for (int q4 = 0; q4 < 4; ++q4) xr[k][q4] = __builtin_nontemporal_load((const f32x4*)(xo + 16 * lane + 4 * q4)); } }
#pragma unroll
    for (int k = 0; k < 4; ++k) { const int tl = C.wave + 8 * k; if (tl < nt) peer_ln2(C, l, t0 + tl, oh[k], xr[k], dry); }
}

__device__ __forceinline__ void phase_peer2(const Ctx& C, int l, bool dry) {
    const unsigned char* S = WSP(unsigned char, B_S);
    const int rows_total = (l == 0) ? M_ALL : M_LAT;
    const int rpb = (((rows_total + C.nb - 1) / C.nb) + 7) & ~7;
    const int rbeg = C.bid * rpb, rend = min(rows_total, rbeg + rpb);
    for (int t0 = rbeg; t0 < rend; t0 += 32) {
        const int nt = min(32, rend - t0);
        for (int c0 = C.tid; c0 < nt * 256; c0 += 4 * NT) {
            u32x4 w[4];
#pragma unroll
            for (int i = 0; i < 4; ++i) { const int c = c0 + i * NT; w[i] = __builtin_nontemporal_load((const u32x4*)(S + (size_t)(t0 + (c >> 8)) * 4096 + (c & 255) * 16)); }
#pragma unroll
            for (int i = 0; i < 4; ++i) { const int c = c0 + i * NT; const int tl = c >> 8, cc = c & 255; *(LAS u32x4*)(C.lds + (tl * 16 + (cc >> 4)) * PG_STRIDE + (cc & 15) * 16) = w[i]; } }
        __syncthreads();
        if (C.tid < nt * 16) {
            LAS unsigned char* gp = C.lds + C.tid * PG_STRIDE;
            unsigned list[16];
#pragma unroll
            for (int p = 0; p < 16; ++p) list[p] = 0u;
#pragma unroll 1
            for (int c = 0; c < 8; ++c) { const u32x4 w0 = *(const LAS u32x4*)(gp + 32 * c), w1 = *(const LAS u32x4*)(gp + 32 * c + 16); unsigned nw[16]; const int ib = 16 * c;
                nw[0] = key_h(w0.x & 0xffffu, ib + 0); nw[1] = key_h(w0.x >> 16, ib + 1); nw[2] = key_h(w0.y & 0xffffu, ib + 2); nw[3] = key_h(w0.y >> 16, ib + 3);
                nw[4] = key_h(w0.z & 0xffffu, ib + 4); nw[5] = key_h(w0.z >> 16, ib + 5); nw[6] = key_h(w0.w & 0xffffu, ib + 6); nw[7] = key_h(w0.w >> 16, ib + 7);
                nw[8] = key_h(w1.x & 0xffffu, ib + 8); nw[9] = key_h(w1.x >> 16, ib + 9); nw[10] = key_h(w1.y & 0xffffu, ib + 10); nw[11] = key_h(w1.y >> 16, ib + 11);
                nw[12] = key_h(w1.z & 0xffffu, ib + 12); nw[13] = key_h(w1.z >> 16, ib + 13); nw[14] = key_h(w1.w & 0xffffu, ib + 14); nw[15] = key_h(w1.w >> 16, ib + 15);
                sort16_desc(nw); merge16_desc(list, nw); }
#pragma unroll
            for (int p = 0; p < 4; ++p) { u32x4 w; w.x = list[4 * p]; w.y = list[4 * p + 1]; w.z = list[4 * p + 2]; w.w = list[4 * p + 3]; *(LAS u32x4*)(gp + 16 * p) = w; }
        }
        __syncthreads();
        if (C.tid < nt * 8) {
            LAS unsigned char* rA = C.lds + (C.tid * 2) * PG_STRIDE; LAS unsigned char* rB = rA + PG_STRIDE;
            float sa[16], sb[16];
#pragma unroll
            for (int p = 0; p < 4; ++p) { const u32x4 a = *(const LAS u32x4*)(rA + 16 * p), b = *(const LAS u32x4*)(rB + 16 * p);
                sa[4 * p] = dec16(a.x); sa[4 * p + 1] = dec16(a.y); sa[4 * p + 2] = dec16(a.z); sa[4 * p + 3] = dec16(a.w);
                sb[4 * p] = dec16(b.x); sb[4 * p + 1] = dec16(b.y); sb[4 * p + 2] = dec16(b.z); sb[4 * p + 3] = dec16(b.w); }
            unsigned cl[16];
#pragma unroll
            for (int p = 0; p < 16; ++p) cl[p] = 0u;
#pragma unroll
            for (int i = 0; i < 16; ++i)
#pragma unroll
                for (int j = 0; j < 16; ++j) if ((i + 1) * (j + 1) <= 16) ins16(cl, (ordf(sa[i] + sb[j]) & ~255u) | (unsigned)(255 - (i * 16 + j)));
            int e[16]; float sc[16];
#pragma unroll
            for (int k = 0; k < 16; ++k) { const unsigned pij = 255u - (cl[k] & 255u); const unsigned ka = *(const LAS unsigned*)(rA + 4 * (pij >> 4)), kb = *(const LAS unsigned*)(rB + 4 * (pij & 15));
                e[k] = (int)((127u - (ka & 127u)) * 128u + (127u - (kb & 127u))); sc[k] = dec16(ka) + dec16(kb); }
            const float mx = sc[0]; float den = 0.f;
#pragma unroll
            for (int k = 0; k < 16; ++k) { sc[k] = __expf(sc[k] - mx); den += sc[k]; }
            const float inv = 1.f / den;
#pragma unroll
            for (int p = 0; p < 4; ++p) { u32x4 w; w.x = (unsigned)e[4 * p]; w.y = (unsigned)e[4 * p + 1]; w.z = (unsigned)e[4 * p + 2]; w.w = (unsigned)e[4 * p + 3]; *(LAS u32x4*)(rA + 16 * p) = w;
                f32x4 g; g[0] = sc[4 * p] * inv; g[1] = sc[4 * p + 1] * inv; g[2] = sc[4 * p + 2] * inv; g[3] = sc[4 * p + 3] * inv; *(LAS f32x4*)(rB + 16 * p) = g; }
        }
        __syncthreads();
#pragma unroll 1
        for (int k = 0; k < 4; ++k) { const int tl = C.wave + 8 * k; if (tl >= nt) break; peer_sort_token(C, tl); }
        wave_sync();
        peer_tokens4(C, l, t0, nt, dry);
        __syncthreads();
    }
}


constexpr size_t WS_CTL = 45 * MiB + 512 * 1024;
constexpr int LDS_BAR_OFF = 147392;
#define XB_TMO      128
#define XB_XCNT(j)  (256  + 64 * (j))
#define XB_XSUB(j)  (1280 + 64 * (j))
#define XB_XGEN(j)  (2304 + 64 * (j))
#define XB_TOP      3328
#define XB_TOPGEN   3392
#define XCD_BAR_WORDS 3456
#define XB_SPIN_CAP (1u << 23)
__device__ __forceinline__ unsigned xb_ld(unsigned* p)              { return __hip_atomic_load(p, __ATOMIC_RELAXED, __HIP_MEMORY_SCOPE_AGENT); }
__device__ __forceinline__ unsigned xb_add(unsigned* p, unsigned v) { return __hip_atomic_fetch_add(p, v, __ATOMIC_RELAXED, __HIP_MEMORY_SCOPE_AGENT); }
__device__ __forceinline__ unsigned xb_xcc_id() { return (unsigned)__builtin_amdgcn_s_getreg((3 << 11) | 20) & 0xFu; }
#define XB_SPIN(cond, bar) do { unsigned _sp = 0; while (cond) { __builtin_amdgcn_s_sleep(1); \
    if ((++_sp & 255u) == 0u) { if (xb_ld(&(bar)[XB_TMO])) break; if (_sp > XB_SPIN_CAP) { atomicAdd(&(bar)[XB_TMO], 1u); break; } } } } while (0)
struct XcdBarrier { unsigned* bar; unsigned x; volatile LAS unsigned* st; bool tid0; };
__device__ __forceinline__ XcdBarrier xcd_barrier_post(unsigned* bar, volatile LAS unsigned* st, bool tid0) {
    XcdBarrier b; b.bar = bar; b.x = xb_xcc_id(); b.st = st; b.tid0 = tid0;
    if (b.tid0) (void)xb_add(&bar[XB_XCNT(b.x)], 1u);
    return b;
}
__device__ __forceinline__ void xcd_barrier_complete(unsigned* bar, unsigned x, unsigned& nloc, unsigned& nx) {
    const unsigned G = gridDim.x * gridDim.y * gridDim.z;
    unsigned sum, cnt, mine, sp = 0u;
    for (;;) {
        sum = 0u; cnt = 0u; mine = 0u;
#pragma unroll
        for (unsigned j = 0; j < 16; ++j) { const unsigned c = xb_ld(&bar[XB_XCNT(j)]); sum += c; cnt += (c > 0u) ? 1u : 0u; mine = (j == x) ? c : mine; }
        if (sum == G) break;
        __builtin_amdgcn_s_sleep(1);
        if ((++sp & 255u) == 0u) { if (xb_ld(&bar[XB_TMO])) break; if (sp > XB_SPIN_CAP) { atomicAdd(&bar[XB_TMO], 1u); break; } }
    }
    nloc = mine > 0u ? mine : 1u; nx = cnt > 0u ? cnt : 1u;
}
__device__ __forceinline__ void xcd_barrier(const XcdBarrier& b) {
    asm volatile("s_waitcnt vmcnt(0)" ::: "memory");
    __syncthreads();
    if (b.tid0) {
        unsigned* bar = b.bar;
        __builtin_amdgcn_s_waitcnt(0);
        unsigned nloc = b.st[0], nx = b.st[1];
        if (nloc == 0u) { xcd_barrier_complete(bar, b.x, nloc, nx); b.st[0] = nloc; b.st[1] = nx; }
        const unsigned old = xb_add(&bar[XB_XSUB(b.x)], 1u);
        const unsigned gen = old / nloc;
        if (old + 1u == (gen + 1u) * nloc) {
            __builtin_amdgcn_fence(__ATOMIC_RELEASE, "agent");
            asm volatile("s_waitcnt vmcnt(0)" ::: "memory");
            const unsigned og = xb_add(&bar[XB_TOP], 1u);
            const unsigned tg = og / nx;
            if (og + 1u == (tg + 1u) * nx) xb_add(&bar[XB_TOPGEN], 1u);
            else XB_SPIN(xb_ld(&bar[XB_TOPGEN]) == tg, bar);
            __builtin_amdgcn_fence(__ATOMIC_ACQUIRE, "agent");
            xb_add(&bar[XB_XGEN(b.x)], 1u);
            asm volatile("s_waitcnt vmcnt(0)" ::: "memory");
        } else {
            XB_SPIN(xb_ld(&bar[XB_XGEN(b.x)]) == gen, bar);
            __builtin_amdgcn_fence(__ATOMIC_ACQUIRE, "agent");
            asm volatile("s_waitcnt vmcnt(0)" ::: "memory");
        }
    }
    __syncthreads();
}

constexpr int LDS_BYTES = 147456;
constexpr int PH_PER_LAYER = 10, N_PHASES = 2 + 2 * PH_PER_LAYER;

__device__ __forceinline__ int lane_now() { int l; asm volatile("v_mbcnt_lo_u32_b32 %0, -1, 0\n\tv_mbcnt_hi_u32_b32 %0, -1, %0" : "=v"(l)); return l; }
__global__ void __launch_bounds__(NT, 2) mega(Args args) {
    extern __shared__ __attribute__((aligned(16))) unsigned char lds_raw[];
    cg::grid_group grid = cg::this_grid();
    Ctx C; C.lds = (LAS unsigned char*)lds_raw; C.bid = blockIdx.x; C.nb = gridDim.x;
    volatile LAS unsigned* bst = (volatile LAS unsigned*)(C.lds + LDS_BAR_OFF);
    const int wv0 = __builtin_amdgcn_readfirstlane((int)(threadIdx.x >> 6));
    { const int t0 = wv0 * 64 + lane_now(); if (t0 < 4) bst[t0] = 0u;
      __syncthreads();
      (void)xcd_barrier_post((unsigned*)(args.ws + WS_CTL), bst, t0 == 0); }
#ifndef FUSE_M1
#define FUSE_M1 1
#endif
#ifndef PH_MASK
#define PH_MASK 0xFFFFFFFFu
#endif
#define EN(k) ((PH_MASK >> (k)) & 1u)
#ifndef DBL_MASK
#define DBL_MASK 0u
#endif
#define REP(k) for (int rep_ = 0; rep_ < 1 + (int)((DBL_MASK >> (k)) & 1u); ++rep_)
    const int lo = args.ph_lo, hi = args.ph_hi;
#ifndef DBLQ_MASK
#define DBLQ_MASK 0u
#endif
    bool again_ = false;
    for (int ph = lo; ph < hi; ++ph) {
        if (FUSE_M1 && ph >= 2 && (ph - 2) % PH_PER_LAYER == 4) continue;
        if (ph > lo) { if (ph == lo + 1) grid.sync(); else { ArgsP ap2 = (ArgsP)__builtin_amdgcn_kernarg_segment_ptr(); asm volatile("" : "+s"(ap2));
            XcdBarrier xb; xb.bar = (unsigned*)(ap2->ws + WS_CTL); xb.x = xb_xcc_id(); xb.st = (volatile LAS unsigned*)(C.lds + LDS_BAR_OFF); xb.tid0 = (wv0 * 64 + lane_now()) == 0; xcd_barrier(xb); } }
        { ArgsP ap = (ArgsP)__builtin_amdgcn_kernarg_segment_ptr(); asm volatile("" : "+s"(ap)); C.a = ap; C.ws = ap->ws; C.wave = wv0; }
#define CTX_TID() do { const int t_ = wv0 * 64 + lane_now(); C.tid = t_; C.lane = t_ & 63; } while (0)
        if (ph == 0) { CTX_TID(); if (EN(10)) REP(16) { phase_mod(C); __syncthreads(); phase_convert(C); __syncthreads(); phase_fold(C); phase_wsb(C); phase_rope_tab(C); __syncthreads(); } continue; }
        if (ph == 1) { CTX_TID(); if (EN(11)) REP(17) phase_h0(C); continue; }
        const int l = (ph - 2) / PH_PER_LAYER, q = (ph - 2) % PH_PER_LAYER;
        unsigned char* wl = C.ws + WS_W + (size_t)l * W_LAYER;
        switch (q) {
        case 0: CTX_TID(); if (EN(0)) REP(0) { pg8::Gemm g{WSP(bf16_t, WS_H), (const bf16_t*)(wl + W_WIN), 1024, 1024, 1024, 1 << 20, 0}; pg8::StaticOrder S; S.init(M_ALL / 256, ZP / 256, C.nb, C.bid);
                  pg8::EpiBf16T<2> E{WSP(bf16_t, B_Z), ZP}; pg8::gemm_phase<pg8::EpiBf16T<2>, true>(C.lds, C.tid, g, S, E); } break;
        case 1: CTX_TID(); if (EN(1)) { REP(10) { phase_gla_a2(C, l); __syncthreads(); } REP(11) phase_na2(C, l); REP(12) phase_conv2(C, l); REP(13) { phase_sgu(C, l); } } break;
        case 2: CTX_TID(); if (EN(2)) phase_gla_scan2(C); break;
        case 3: CTX_TID(); if (EN(3)) { REP(14) { phase_gla_out2(C, l); } } break;
        case 4: CTX_TID(); if (EN(4) && !FUSE_M1) REP(4) { pg8::Gemm g{WSP(bf16_t, WS_Y), (const bf16_t*)(wl + W_WB), 1024, 256, 256, 4, 256}; pg8::StaticOrder S; S.init(l == 0 ? M_ALL / 256 : M_LAT / 256, 16, C.nb, C.bid);
                  pg8::EpiBf16T<1> E{WSP(bf16_t, B_P), 4096}; pg8::gemm_phase<pg8::EpiBf16T<1>, true>(C.lds, C.tid, g, S, E); } break;
        case 5: CTX_TID(); if (EN(5)) REP(5) {
#if FUSE_M1
                  pg8::FusedArgs fa{WSP(bf16_t, WS_H), (const bf16_t*)(wl + W_WG), WSP(bf16_t, WS_Y), (const bf16_t*)(wl + W_WB), WSP(bf16_t, B_P)};
                  pg8::StaticOrder S; S.init(l == 0 ? M_ALL / 256 : M_LAT / 256, 16, C.nb, C.bid);
                  pg8::gemm_gates_fused(C.lds, C.tid, fa, S); } break;
#else
 pg8::Gemm g{WSP(bf16_t, WS_H), (const bf16_t*)(wl + W_WG), 1024, 1024, 1024, 1 << 20, 0}; pg8::StaticOrder S; S.init(l == 0 ? M_ALL / 256 : M_LAT / 256, 16, C.nb, C.bid, 1);
                  pg8::EpiMerge E{WSP(bf16_t, B_P), WSP(bf16_t, WS_Y)}; pg8::gemm_phase<pg8::EpiMerge, true>(C.lds, C.tid, g, S, E); } break;
#endif
        case 6: CTX_TID(); if (EN(6)) REP(6) { pg8::Gemm g{FUSE_M1 ? WSP(bf16_t, B_P) : WSP(bf16_t, WS_Y), (const bf16_t*)(wl + W_WO), 1024, 1024, 1024, 1 << 20, 0}; pg8::StaticOrder S; S.init(l == 0 ? M_ALL / 256 : M_LAT / 256, 4, C.nb, C.bid);
                  pg8::EpiBf16T<1> E{WSP(bf16_t, WS_H), 1024}; pg8::gemm_phase<pg8::EpiBf16T<1>, true>(C.lds, C.tid, g, S, E); } break;
        case 7: CTX_TID(); if (EN(7)) { phase_ln1(C, l); REP(7) phase_tables6(C, l); } break;
        case 8: CTX_TID(); if (EN(8)) REP(8) { pg8::Gemm g{WSP(bf16_t, WS_H), (const bf16_t*)(wl + W_WS), 1024, 1024, 1024, 1 << 20, 0}; pg8::StaticOrder S; S.init(l == 0 ? M_ALL / 256 : M_LAT / 256, 8, C.nb, C.bid);
                  pg8::EpiF16 E{WSP(unsigned short, B_S), 2048}; pg8::gemm_phase<pg8::EpiF16, true>(C.lds, C.tid, g, S, E); } break;
        case 9: CTX_TID(); if (EN(9)) { REP(9) phase_peer2(C, l, (DBL_MASK >> 9) & 1u ? rep_ == 0 : false); } break;
        default: break;
        }
        if (ph == N_PHASES - 1 && C.bid == 0 && (wv0 * 64 + lane_now()) == 0 && !fp6_roundtrip_ok()) { ArgsP ap3 = (ArgsP)__builtin_amdgcn_kernarg_segment_ptr(); ap3->out[0] = __builtin_nanf(""); }
        if (DBLQ_MASK != 0u) { if (!again_ && ((DBLQ_MASK >> q) & 1u)) { again_ = true; --ph; } else again_ = false; }
    }
}

extern "C" void kernel_launch(void* const* d_in, const int* in_sizes, int n_in, void* d_out, int out_size, void* d_ws, size_t ws_size, hipStream_t stream) {
    static int grid = 0;
    if (grid == 0) {
        if (n_in != 29 || out_size != M_LAT * DM || ws_size < WS_NEED) { fprintf(stderr, "kernel_launch: unexpected shapes (n_in %d, out %d, ws %zu < %zu)\n", n_in, out_size, ws_size, (size_t)WS_NEED); grid = -1; return; }
        int dev = 0, cus = 0, per_cu = 0;
        hipGetDevice(&dev); hipDeviceGetAttribute(&cus, hipDeviceAttributeMultiprocessorCount, dev);
        if (hipFuncSetAttribute((const void*)mega, hipFuncAttributeMaxDynamicSharedMemorySize, LDS_BYTES) != hipSuccess) { fprintf(stderr, "kernel_launch: hipFuncSetAttribute failed\n"); grid = -1; return; }
        if (hipOccupancyMaxActiveBlocksPerMultiprocessor(&per_cu, (const void*)mega, NT, LDS_BYTES) != hipSuccess || per_cu < 1) { fprintf(stderr, "kernel_launch: occupancy query failed (%d)\n", per_cu); (void)hipGetLastError(); per_cu = 1; }
        grid = cus * 1;
        fprintf(stderr, "kernel_launch: cus %d per_cu %d grid %d ws %zu\n", cus, per_cu, grid, ws_size);
    }
    if (grid < 0) return;
    if (hipMemsetAsync((char*)d_ws + WS_CTL, 0, 16384, stream) != hipSuccess) { fprintf(stderr, "kernel_launch: memset failed\n"); return; }
    Args a{};
    for (int i = 0; i < 29; ++i) a.in[i] = (const float*)d_in[i];
    a.out = (float*)d_out; a.ws = (unsigned char*)d_ws;
#ifndef SINGLE_LAUNCH
#define SINGLE_LAUNCH 1
#endif
    if (SINGLE_LAUNCH) {
        a.ph_lo = 0; a.ph_hi = N_PHASES; void* kargs[] = {&a};
        hipError_t e = hipLaunchCooperativeKernel((void*)mega, dim3(grid), dim3(NT), kargs, LDS_BYTES, stream);
        if (e != hipSuccess) fprintf(stderr, "cooperative launch failed: %s\n", hipGetErrorString(e));
    } else {
        for (int ph = 0; ph < N_PHASES; ++ph) {
            a.ph_lo = ph; a.ph_hi = ph + 1; void* kargs[] = {&a};
            hipError_t e = hipLaunchCooperativeKernel((void*)mega, dim3(grid), dim3(NT), kargs, LDS_BYTES, stream);
            if (e != hipSuccess) { fprintf(stderr, "cooperative launch (phase %d) failed: %s\n", ph, hipGetErrorString(e)); break; }
        }
    }
}
```

```cpp
#include <hip/hip_runtime.h>
#include <hip/hip_cooperative_groups.h>
#include <cstdio>
#include <cstdint>
namespace cg = cooperative_groups;

#define LAS __attribute__((address_space(3)))
typedef unsigned short bf16_t;
typedef short bf16x8 __attribute__((ext_vector_type(8)));
typedef float f32x4 __attribute__((ext_vector_type(4)));
typedef float f32x2 __attribute__((ext_vector_type(2)));
typedef unsigned u32x4 __attribute__((ext_vector_type(4)));
typedef unsigned u32x2 __attribute__((ext_vector_type(2)));

constexpr int NT = 512;
constexpr int M_LAT = 32768, M_CTX = 2048, M_ALL = 34816, DM = 1024;
constexpr int SEQ = 4096, CTXL = 256;
constexpr int WIN_COLS = 6688;
constexpr int ZP = 2816;
constexpr int ZQ = 0, ZK = 256, ZV = 512, ZGQ = 768, ZGK = 896, ZGV = 1024, ZGR = 1280, ZLO = 1536, ZCA = 1568, ZCG = 1824, ZSU = 2080, ZSV = 2336, ZGATE = 2592;
constexpr float ALPHA = 1.41421356237309515f;
constexpr float LN_EPS = 1e-6f;

constexpr size_t MiB = 1u << 20;
constexpr size_t W_WIN = 0, W_WG = 5767168, W_WB = W_WG + 8388608, W_WO = W_WB + 2097152, W_WS = W_WO + 2097152, W_LAYER = W_WS + 4194304;
constexpr size_t WS_W = 0;
constexpr size_t WS_MOD = 44 * MiB;
constexpr size_t WS_H = 46 * MiB;
constexpr size_t WS_Y = 114 * MiB;
constexpr size_t WS_XC = 182 * MiB;
constexpr size_t WS_BIG = 190 * MiB;
constexpr size_t B_Z = WS_BIG;
constexpr size_t B_AF = WS_BIG + 187 * MiB;
constexpr size_t B_AB = B_AF + 17 * MiB;
constexpr size_t B_QP = B_AB + 17 * MiB;
constexpr size_t B_KP = B_QP + 17 * MiB / 2;
constexpr size_t B_OF = B_KP + 17 * MiB / 2;
constexpr size_t B_OB = B_OF + 17 * MiB;
constexpr size_t B_VN = B_OB + 17 * MiB;
constexpr size_t B_P = WS_BIG;
constexpr size_t B_S = WS_BIG;
constexpr size_t B_TU = WS_BIG + 136 * MiB;
constexpr size_t B_TV = B_TU + 32 * MiB;
constexpr size_t WS_NEED = WS_BIG + 323 * MiB;

__device__ __forceinline__ float bf2f(bf16_t v) { return __uint_as_float((unsigned)v << 16); }
typedef __bf16 bf16x2_t __attribute__((ext_vector_type(2)));
__device__ __forceinline__ unsigned pk2(float lo, float hi) { const f32x2 v = {lo, hi}; return __builtin_bit_cast(unsigned, __builtin_convertvector(v, bf16x2_t)); }
__device__ __forceinline__ unsigned f2bf(float f) { return pk2(f, 0.f) & 0xffffu; }
__device__ __forceinline__ float lo16(unsigned u) { return __uint_as_float(u << 16); }
__device__ __forceinline__ float hi16(unsigned u) { return __uint_as_float(u & 0xffff0000u); }
__device__ __forceinline__ float sigmoidf_(float x) { return __builtin_amdgcn_rcpf(1.f + __expf(-x)); }
__device__ __forceinline__ float siluf_(float x) { return x * __builtin_amdgcn_rcpf(1.f + __expf(-x)); }
__device__ __forceinline__ float gelu_tanh(float x) { const float y2 = -2.3022081981244260f * (x + 0.044715f * x * x * x); return x * __builtin_amdgcn_rcpf(1.f + __builtin_amdgcn_exp2f(y2)); }
__device__ __forceinline__ float wave_sum(float v) {
    v += __int_as_float(__builtin_amdgcn_update_dpp(0, __float_as_int(v), 0xB1, 0xF, 0xF, false));
    v += __int_as_float(__builtin_amdgcn_update_dpp(0, __float_as_int(v), 0x4E, 0xF, 0xF, false));
    v += __int_as_float(__builtin_amdgcn_update_dpp(0, __float_as_int(v), 0x141, 0xF, 0xF, false));
    v += __int_as_float(__builtin_amdgcn_update_dpp(0, __float_as_int(v), 0x140, 0xF, 0xF, false));
    { const auto r = __builtin_amdgcn_permlane16_swap(__float_as_uint(v), __float_as_uint(v), false, false); v = __uint_as_float(r[0]) + __uint_as_float(r[1]); }
    { const auto r = __builtin_amdgcn_permlane32_swap(__float_as_uint(v), __float_as_uint(v), false, false); v = __uint_as_float(r[0]) + __uint_as_float(r[1]); }
    return v;
}
__device__ __forceinline__ float xor16_32_sum(float v) {
    { const auto r = __builtin_amdgcn_permlane16_swap(__float_as_uint(v), __float_as_uint(v), false, false); v = __uint_as_float(r[0]) + __uint_as_float(r[1]); }
    { const auto r = __builtin_amdgcn_permlane32_swap(__float_as_uint(v), __float_as_uint(v), false, false); v = __uint_as_float(r[0]) + __uint_as_float(r[1]); }
    return v;
}
__device__ __forceinline__ float xor16_32_max(float v) {
    { const auto r = __builtin_amdgcn_permlane16_swap(__float_as_uint(v), __float_as_uint(v), false, false); v = fmaxf(__uint_as_float(r[0]), __uint_as_float(r[1])); }
    { const auto r = __builtin_amdgcn_permlane32_swap(__float_as_uint(v), __float_as_uint(v), false, false); v = fmaxf(__uint_as_float(r[0]), __uint_as_float(r[1])); }
    return v;
}
__device__ __forceinline__ void wave_sync() { __builtin_amdgcn_fence(__ATOMIC_RELEASE, "wavefront"); __builtin_amdgcn_wave_barrier(); __builtin_amdgcn_fence(__ATOMIC_ACQUIRE, "wavefront"); }
__device__ __forceinline__ float rdlane(float v, int l) { return __int_as_float(__builtin_amdgcn_readlane(__float_as_int(v), l)); }
__device__ __forceinline__ void unpack8(const u32x4 v, float* o) { o[0] = lo16(v.x); o[1] = hi16(v.x); o[2] = lo16(v.y); o[3] = hi16(v.y); o[4] = lo16(v.z); o[5] = hi16(v.z); o[6] = lo16(v.w); o[7] = hi16(v.w); }
__device__ __forceinline__ int mod_index(int m) { return m < M_LAT ? (m >> 12) : 8; }

namespace pg8 {
constexpr int BM = 256, BK = 64, HALF = 128, HTB = HALF * BK * 2, STAGE_BYTES = 8 * HTB, NXCD = 8, WGM = 8;
__host__ __device__ __forceinline__ int lds_byte(int r, int c) { const int st = (r >> 4) * 2 + (c >> 5), rr = r & 15, cc = c & 31, ob = rr * 64 + cc * 2; return st * 1024 + (ob ^ (((ob >> 9) & 1) << 5)); }
__host__ __device__ __forceinline__ void stage_rc(int b, int& R, int& C) { const int st = b / 1024, sb = b % 1024, swz = sb ^ (((sb >> 9) & 1) << 5); R = (st >> 1) * 16 + swz / 64; C = (st & 1) * 32 + (swz % 64) / 2; }
__host__ __device__ __forceinline__ int perm32(int rho) { const int n = rho >> 4, i = rho & 15; return 8 * (i >> 2) + 4 * n + (i & 3); }
struct Unit { int pm, pn; };
struct Gemm { const bf16_t* A; const bf16_t* Bt; int lda, ldb, K; int agrp, acol; };
struct StaticOrder {
    int nM, nN, nwg, G, c, rev;
    __device__ void init(int nM_, int nN_, int G_, int c_, int rev_ = 0) { nM = nM_; nN = nN_; nwg = nM * nN; G = G_; c = c_; rev = rev_; }
    __device__ bool next(int i, Unit& u) const {
        const long L = (long)i * G + c; if (L >= nwg) return false;
        int wgid = (int)L; { const int q = nwg / NXCD, r = nwg % NXCD, xcd = wgid % NXCD, off = wgid / NXCD; wgid = (xcd < r ? xcd * (q + 1) : r * (q + 1) + (xcd - r) * q) + off; }
        const int nig = WGM * nN, gid = wgid / nig, fm = gid * WGM, gsz = (nM - fm) < WGM ? (nM - fm) : WGM;
        u.pm = fm + ((wgid % nig) % gsz); u.pn = (wgid % nig) / gsz; if (rev) u.pm = nM - 1 - u.pm; return true;
    }
};
__device__ __forceinline__ unsigned cvt_pk_bf16(float lo, float hi) { unsigned r; asm volatile("v_cvt_pk_bf16_f32 %0, %1, %2" : "=v"(r) : "v"(lo), "v"(hi)); return r; }
__device__ __forceinline__ unsigned cvt_pk_bf16_t(float lo, float hi) { unsigned r; asm volatile("s_nop 1\n\tv_cvt_pk_bf16_f32 %0, %1, %2" : "=v"(r) : "v"(lo), "v"(hi)); return r; }

__device__ __forceinline__ unsigned ror8(unsigned v) { return (unsigned)__builtin_amdgcn_update_dpp(0, (int)v, 0x128, 0xF, 0xF, false); }
__device__ __forceinline__ void line_pair(const u32x4& x0, const u32x4& x1, bool hi, u32x4& a, u32x4& b) {
#pragma unroll
    for (int d = 0; d < 4; ++d) { const unsigned t = ror8(hi ? x0[d] : x1[d]); a[d] = hi ? t : x0[d]; b[d] = hi ? x1[d] : t; }
}
template <int PM> struct EpiBf16T;
template <> struct EpiBf16T<1> {
    static constexpr int PERM = 1;
    bf16_t* O; int ldc;
    __device__ __forceinline__ void operator()(const f32x4 (&acc)[2][2][4][2], const Unit& u, int wr, int wc, int fr, int fq) const {
        const int row0 = u.pm * BM + wr * 64 + fr; const int col0 = u.pn * BM + wc * 32 + 8 * fq;
#pragma unroll
        for (int ai = 0; ai < 2; ++ai)
#pragma unroll
            for (int m = 0; m < 4; ++m) { bf16_t* rowp = O + (size_t)(row0 + ai * HALF + m * 16) * ldc + col0;
#pragma unroll
                for (int bj = 0; bj < 2; ++bj) { const f32x4 v0 = acc[ai][bj][m][0], v1 = acc[ai][bj][m][1];
                    u32x4 w; w.x = cvt_pk_bf16(v0[0], v0[1]); w.y = cvt_pk_bf16(v0[2], v0[3]); w.z = cvt_pk_bf16(v1[0], v1[1]); w.w = cvt_pk_bf16(v1[2], v1[3]);
                    *(u32x4*)(rowp + bj * HALF) = w; } }
    }
};
template <> struct EpiBf16T<2> {
    static constexpr int PERM = 2;
    bf16_t* O; int ldc;
    __device__ __forceinline__ void operator()(const f32x4 (&acc)[2][2][4][2], const Unit& u, int wr, int wc, int fr, int fq) const {
        const bool hi = (fr >> 3) != 0;
        const int row0 = u.pm * BM + wr * 64 + (fr & 7); const int col0 = u.pn * BM + wc * 64 + ((fr >> 3) * 4 + fq) * 8;
#pragma unroll
        for (int ai = 0; ai < 2; ++ai)
#pragma unroll
            for (int m = 0; m < 4; ++m) { bf16_t* rowp = O + (size_t)(row0 + ai * HALF + m * 16) * ldc + col0;
                u32x4 x[2];
#pragma unroll
                for (int bj = 0; bj < 2; ++bj) { const f32x4 v0 = acc[ai][bj][m][0], v1 = acc[ai][bj][m][1];
                    x[bj].x = cvt_pk_bf16(v0[0], v0[1]); x[bj].y = cvt_pk_bf16(v0[2], v0[3]); x[bj].z = cvt_pk_bf16(v1[0], v1[1]); x[bj].w = cvt_pk_bf16(v1[2], v1[3]); }
                u32x4 a, b; line_pair(x[0], x[1], hi, a, b);
                *(u32x4*)rowp = a; *(u32x4*)(rowp + (size_t)8 * ldc) = b; }
    }
};
typedef _Float16 h16x2 __attribute__((ext_vector_type(2)));
__device__ __forceinline__ unsigned pk_f16(float a, float b) { h16x2 h; h.x = (_Float16)a; h.y = (_Float16)b; return __builtin_bit_cast(unsigned, h); }
struct EpiF16 {
    static constexpr int PERM = 2;
    unsigned short* O; int ldc;
    __device__ __forceinline__ void operator()(const f32x4 (&acc)[2][2][4][2], const Unit& u, int wr, int wc, int fr, int fq) const {
        const bool hi = (fr >> 3) != 0;
        const int row0 = u.pm * BM + wr * 64 + (fr & 7); const int col0 = u.pn * BM + wc * 64 + ((fr >> 3) * 4 + fq) * 8;
#pragma unroll
        for (int ai = 0; ai < 2; ++ai)
#pragma unroll
            for (int m = 0; m < 4; ++m) { unsigned short* rowp = O + (size_t)(row0 + ai * HALF + m * 16) * ldc + col0;
                u32x4 x[2];
#pragma unroll
                for (int bj = 0; bj < 2; ++bj) { const f32x4 v0 = acc[ai][bj][m][0], v1 = acc[ai][bj][m][1];
                    x[bj].x = pk_f16(v0[0], v0[1]); x[bj].y = pk_f16(v0[2], v0[3]); x[bj].z = pk_f16(v1[0], v1[1]); x[bj].w = pk_f16(v1[2], v1[3]); }
                u32x4 a, b; line_pair(x[0], x[1], hi, a, b);
                *(u32x4*)rowp = a; *(u32x4*)(rowp + (size_t)8 * ldc) = b; }
    }
};
struct EpiMerge {
    static constexpr int PERM = 0;
    const bf16_t* P; bf16_t* O;
    __device__ __forceinline__ void operator()(const f32x4 (&acc)[2][2][4][2], const Unit& u, int wr, int wc, int fr, int fq) const {
        const int row0 = u.pm * BM + wr * 64 + fr; const int oc = u.pn * 64 + wc * 16 + 4 * fq;
#pragma unroll
        for (int ai = 0; ai < 2; ++ai) {
            u32x2 pv[4][4];
#pragma unroll
            for (int m = 0; m < 4; ++m) { const size_t row = (size_t)(row0 + ai * HALF + m * 16);
#pragma unroll
                for (int br = 0; br < 4; ++br) pv[m][br] = *(const u32x2*)(P + row * 4096 + br * 1024 + oc); }
#pragma unroll
            for (int m = 0; m < 4; ++m) { const size_t row = (size_t)(row0 + ai * HALF + m * 16);
                f32x4 s = (f32x4){0.f, 0.f, 0.f, 0.f};
#pragma unroll
                for (int bj = 0; bj < 2; ++bj)
#pragma unroll
                    for (int n = 0; n < 2; ++n) { const int br = 2 * bj + n; const u32x2 p2 = pv[m][br]; const f32x4 g = acc[ai][bj][m][n];
                        s[0] += __builtin_amdgcn_rcpf(1.f + __expf(-g[0])) * __uint_as_float(p2.x << 16); s[1] += __builtin_amdgcn_rcpf(1.f + __expf(-g[1])) * __uint_as_float(p2.x & 0xffff0000u);
                        s[2] += __builtin_amdgcn_rcpf(1.f + __expf(-g[2])) * __uint_as_float(p2.y << 16); s[3] += __builtin_amdgcn_rcpf(1.f + __expf(-g[3])) * __uint_as_float(p2.y & 0xffff0000u); }
                u32x2 w; w.x = cvt_pk_bf16(s[0], s[1]); w.y = cvt_pk_bf16(s[2], s[3]);
                *(u32x2*)(O + row * 1024 + oc) = w; } }
    }
};

template <class Epi, bool ALIGN_EPI>
__device__ __forceinline__ void gemm_phase(LAS unsigned char* lds, const int tid, const Gemm g, const StaticOrder& S, const Epi& E) {
    const int wid = __builtin_amdgcn_readfirstlane(tid >> 6), lane = tid & 63, wr = wid >> 2, wc = wid & 3, fr = lane & 15, fq = lane >> 4;
    const int K = g.K, nt = K / BK;
    unsigned voffA[2], voffB[2];
#pragma unroll
    for (int i = 0; i < 2; ++i) { int R, C; stage_rc(tid * 16 + i * 8192, R, C); const int Rb = Epi::PERM == 2 ? (64 * (R >> 5) + perm32(R & 31)) : Epi::PERM == 1 ? ((R & ~31) + perm32(R & 31)) : R;
        voffA[i] = (unsigned)(R * g.lda + C) * 2u; voffB[i] = (unsigned)(Rb * g.ldb + C) * 2u; }
    const size_t kstep = (size_t)(BK * 2);
    const size_t hstepA = (size_t)HALF * g.lda * 2, hstepB = (size_t)(Epi::PERM == 2 ? 32 : HALF) * g.ldb * 2;
    const size_t tstepA = 2 * hstepA, tstepB = (size_t)BM * g.ldb * 2;
    const unsigned ldsw = (unsigned)wid * 1024u;
    const int aoff = lds_byte(wr * 64 + fr, fq * 8), boff = lds_byte(wc * 32 + fr, fq * 8);
#define PG8_SA(b, h) (((b) * 2 + (h)) * HTB)
#define PG8_SB(b, h) ((4 + (b) * 2 + (h)) * HTB)
#define PG8_STAGE(bufoff, gbase, voff) do { const char* _gb = (const char*)(gbase); asm volatile("" : "+s"(_gb));   \
        _Pragma("unroll") for (int _i = 0; _i < 2; ++_i) \
        __builtin_amdgcn_global_load_lds((const unsigned*)(_gb + (voff)[_i]), (LAS unsigned*)(lds + (bufoff) + ldsw + _i * 8192), 16, 0, 0); } while (0)
#define PG8_LDA(dst, b, h) do { _Pragma("unroll") for (int m = 0; m < 4; ++m) _Pragma("unroll") for (int k = 0; k < 2; ++k) dst[m][k] = *(const LAS bf16x8*)(lds + PG8_SA(b, h) + aoff + m * 2048 + k * 1024); } while (0)
#define PG8_LDB(dst, b, h) do { _Pragma("unroll") for (int n = 0; n < 2; ++n) _Pragma("unroll") for (int k = 0; k < 2; ++k) dst[n][k] = *(const LAS bf16x8*)(lds + PG8_SB(b, h) + boff + n * 2048 + k * 1024); } while (0)
#define PG8_MMA(ai, bj, At, Bt) do { __builtin_amdgcn_s_setprio(1); _Pragma("unroll") for (int m = 0; m < 4; ++m) _Pragma("unroll") for (int n = 0; n < 2; ++n) _Pragma("unroll") for (int k = 0; k < 2; ++k) \
        acc[ai][bj][m][n] = __builtin_amdgcn_mfma_f32_16x16x32_bf16(Bt[n][k], At[m][k], acc[ai][bj][m][n], 0, 0, 0); __builtin_amdgcn_s_setprio(0); } while (0)
#define PG8_WAIT_V(n) asm volatile("s_waitcnt vmcnt(" #n ")" ::: "memory")
#define PG8_WAIT_L(n) asm volatile("s_waitcnt lgkmcnt(" #n ")" ::: "memory")
#define PG8_BAR __builtin_amdgcn_s_barrier()
#define PG8_SCHED __builtin_amdgcn_sched_barrier(0)
#define PG8_UA(u) ((const char*)g.A + (size_t)(u).pm * tstepA + (size_t)(((u).pn / g.agrp) * g.acol) * 2)
#define PG8_UB(u) ((const char*)g.Bt + (size_t)(u).pn * tstepB)
    Unit cur, nxt; int ui = 0;
    if (!S.next(0, cur)) return;
    f32x4 acc[2][2][4][2];
#pragma unroll
    for (int a = 0; a < 2; ++a)
#pragma unroll
        for (int b = 0; b < 2; ++b)
#pragma unroll
            for (int m = 0; m < 4; ++m)
#pragma unroll
                for (int n = 0; n < 2; ++n) acc[a][b][m][n] = (f32x4){0.f, 0.f, 0.f, 0.f};
    bf16x8 At[4][2], B0[2][2], B1[2][2];
    const char* cA = PG8_UA(cur); const char* cB = PG8_UB(cur);
    PG8_STAGE(PG8_SB(0, 0), cB, voffB); PG8_STAGE(PG8_SB(0, 1), cB + hstepB, voffB); PG8_STAGE(PG8_SA(0, 0), cA, voffA); PG8_STAGE(PG8_SA(0, 1), cA + hstepA, voffA);
    if (wr == 1) PG8_BAR;
    PG8_WAIT_V(2); PG8_BAR;
    PG8_STAGE(PG8_SB(1, 0), cB + kstep, voffB); PG8_STAGE(PG8_SA(1, 0), cA + kstep, voffA); PG8_STAGE(PG8_SB(1, 1), cB + hstepB + kstep, voffB);
    PG8_WAIT_V(6); PG8_BAR;
    for (;;) {
        const bool has_next = S.next(ui + 1, nxt);
        const char* nA = has_next ? PG8_UA(nxt) : cA; const char* nB = has_next ? PG8_UB(nxt) : cB;
#pragma unroll 1
        for (int t = 0; t < nt; t += 2) {
            const bool last = (t == nt - 2);
            const char* a1 = cA + (size_t)(t + 1) * kstep;
            const char* a2 = last ? nA : cA + (size_t)(t + 2) * kstep; const char* b2 = last ? nB : cB + (size_t)(t + 2) * kstep;
            const char* a3 = a2 + kstep; const char* b3 = b2 + kstep;
            PG8_LDB(B0, 0, 0); PG8_LDB(B1, 0, 1); PG8_SCHED; PG8_LDA(At, 0, 0); PG8_STAGE(PG8_SA(1, 1), a1 + hstepA, voffA);
            PG8_WAIT_V(8); PG8_WAIT_L(0); PG8_BAR; PG8_MMA(0, 0, At, B0); PG8_MMA(0, 1, At, B1); PG8_BAR; PG8_SCHED;
            PG8_LDA(At, 0, 1); PG8_STAGE(PG8_SB(0, 0), b2, voffB); PG8_STAGE(PG8_SB(0, 1), b2 + hstepB, voffB); PG8_STAGE(PG8_SA(0, 0), a2, voffA);
            PG8_WAIT_V(8); PG8_WAIT_L(0); PG8_BAR; PG8_MMA(1, 0, At, B0); PG8_MMA(1, 1, At, B1); PG8_BAR; PG8_SCHED;
            PG8_LDB(B0, 1, 0); PG8_LDB(B1, 1, 1); PG8_SCHED; PG8_LDA(At, 1, 0); PG8_STAGE(PG8_SA(0, 1), a2 + hstepA, voffA);
            PG8_WAIT_V(8); PG8_WAIT_L(0); PG8_BAR; PG8_MMA(0, 0, At, B0); PG8_MMA(0, 1, At, B1); PG8_BAR; PG8_SCHED;
            PG8_LDA(At, 1, 1); PG8_STAGE(PG8_SB(1, 0), b3, voffB); PG8_STAGE(PG8_SB(1, 1), b3 + hstepB, voffB); PG8_STAGE(PG8_SA(1, 0), a3, voffA);
            PG8_WAIT_V(8); PG8_WAIT_L(0); PG8_BAR; PG8_MMA(1, 0, At, B0); PG8_MMA(1, 1, At, B1); PG8_BAR; PG8_SCHED;
        }
        if constexpr (ALIGN_EPI) { if (wr == 0) PG8_BAR; }
        E(acc, cur, wr, wc, fr, fq);
        if (!has_next) break;
#pragma unroll
        for (int a = 0; a < 2; ++a)
#pragma unroll
            for (int b = 0; b < 2; ++b)
#pragma unroll
                for (int m = 0; m < 4; ++m)
#pragma unroll
                    for (int n = 0; n < 2; ++n) acc[a][b][m][n] = (f32x4){0.f, 0.f, 0.f, 0.f};
        cur = nxt; cA = nA; cB = nB; ++ui;
        if constexpr (ALIGN_EPI) { if (wr == 1) PG8_BAR; }
    }
    PG8_WAIT_V(0);
    if constexpr (!ALIGN_EPI) { if (wr == 0) PG8_BAR; }
    PG8_BAR;
#undef PG8_SA
#undef PG8_SB
#undef PG8_STAGE
#undef PG8_LDA
#undef PG8_LDB
#undef PG8_MMA
#undef PG8_WAIT_V
#undef PG8_WAIT_L
#undef PG8_BAR
#undef PG8_SCHED
#undef PG8_UA
#undef PG8_UB
}
struct FusedArgs { const bf16_t* H; const bf16_t* WG; const bf16_t* Y; const bf16_t* WB; bf16_t* O; };
__device__ __forceinline__ void gemm_gates_fused(LAS unsigned char* lds, const int tid, const FusedArgs g, const StaticOrder& S) {
    const int wid = __builtin_amdgcn_readfirstlane(tid >> 6), lane = tid & 63, wr = wid >> 2, wc = wid & 3, fr = lane & 15, fq = lane >> 4;
    unsigned voffA[2];
#pragma unroll
    for (int i = 0; i < 2; ++i) { int R, C; stage_rc(tid * 16 + i * 8192, R, C); voffA[i] = (unsigned)(R * 1024 + C) * 2u; }
    const size_t kstep = (size_t)(BK * 2);
    const size_t hstepA = (size_t)HALF * 1024 * 2, hstepB = hstepA, tstep = 2 * hstepA;
    const unsigned ldsw = (unsigned)wid * 1024u;
    const unsigned ldsp = (unsigned)(((wid >> 1) * 4 + (wid & 1)) * 1024);
    const int aoff = lds_byte(wr * 64 + fr, fq * 8), boff = lds_byte(wc * 32 + fr, fq * 8);
#define PG8_SA(b, h) (((b) * 2 + (h)) * HTB)
#define PG8_SB(b, h) ((4 + (b) * 2 + (h)) * HTB)
#define PG8_STAGE(bufoff, gbase, voff) do { const char* _gb = (const char*)(gbase); asm volatile("" : "+s"(_gb));   \
        _Pragma("unroll") for (int _i = 0; _i < 2; ++_i) \
        __builtin_amdgcn_global_load_lds((const unsigned*)(_gb + (voff)[_i]), (LAS unsigned*)(lds + (bufoff) + ldsw + _i * 8192), 16, 0, 0); } while (0)
#define PG8_LDA(dst, b, h) do { _Pragma("unroll") for (int m = 0; m < 4; ++m) _Pragma("unroll") for (int k = 0; k < 2; ++k) dst[m][k] = *(const LAS bf16x8*)(lds + PG8_SA(b, h) + aoff + m * 2048 + k * 1024); } while (0)
#define PG8_LDB(dst, b, h) do { _Pragma("unroll") for (int n = 0; n < 2; ++n) _Pragma("unroll") for (int k = 0; k < 2; ++k) dst[n][k] = *(const LAS bf16x8*)(lds + PG8_SB(b, h) + boff + n * 2048 + k * 1024); } while (0)
#define PG8_MMA(ai, bj, At, Bt) do { __builtin_amdgcn_s_setprio(1); _Pragma("unroll") for (int m = 0; m < 4; ++m) _Pragma("unroll") for (int n = 0; n < 2; ++n) _Pragma("unroll") for (int k = 0; k < 2; ++k) \
        acc[ai][bj][m][n] = __builtin_amdgcn_mfma_f32_16x16x32_bf16(Bt[n][k], At[m][k], acc[ai][bj][m][n], 0, 0, 0); __builtin_amdgcn_s_setprio(0); } while (0)
#define PG8_WAIT_V(n) asm volatile("s_waitcnt vmcnt(" #n ")" ::: "memory")
#define PG8_WAIT_L(n) asm volatile("s_waitcnt lgkmcnt(" #n ")" ::: "memory")
#define PG8_BAR __builtin_amdgcn_s_barrier()
#define PG8_SCHED __builtin_amdgcn_sched_barrier(0)
#define F_LDB_G(b, bj, n) do { PG8_LDB(B0, b, 0); PG8_LDB(B1, b, 1); } while (0)
#define F_LDB_P(b, bj, n) do { _Pragma("unroll") for (int k = 0; k < 2; ++k) Bp[k] = *(const LAS bf16x8*)(lds + PG8_SB(b, bj) + boff + (n) * 2048 + k * 1024); } while (0)
#define F_MMA_G(ai) do { PG8_MMA(ai, 0, At, B0); PG8_MMA(ai, 1, At, B1); } while (0)
#define F_MMA_P(ai) do { __builtin_amdgcn_s_setprio(1); _Pragma("unroll") for (int k = 0; k < 2; ++k) _Pragma("unroll") for (int m = 0; m < 4; ++m) \
        pacc[ai][m] = __builtin_amdgcn_mfma_f32_16x16x32_bf16(Bp[k], At[m][k], pacc[ai][m], 0, 0, 0); __builtin_amdgcn_s_setprio(0); } while (0)
#define F_STB_G(b, bj, n, bptr) do { PG8_STAGE(PG8_SB(b, 0), bptr, vo); PG8_STAGE(PG8_SB(b, 1), (bptr) + hstepB, vo); } while (0)
#define F_STB_P(b, bj, n, bptr) do { const char* _gb = (const char*)(bptr); asm volatile("" : "+s"(_gb)); __builtin_amdgcn_global_load_lds((const unsigned*)(_gb + vp), (LAS unsigned*)(lds + PG8_SB(b, bj) + ldsp + (n) * 2048), 16, 0, 0); } while (0)
#define F_TRIP_BODY(LDB0, MMA0, bj0, n0, LDB1, MMA1, bj1, n1, A1, STB2, bj2, n2, B2, A2, STB3, bj3, n3, B3, A3, W1, W2, W3, W4) \
        LDB0(0, bj0, n0); PG8_SCHED; PG8_LDA(At, 0, 0); PG8_STAGE(PG8_SA(1, 1), (A1) + hstepA, vo); \
        PG8_WAIT_V(W1); PG8_WAIT_L(0); PG8_BAR; MMA0(0); PG8_BAR; PG8_SCHED; \
        PG8_LDA(At, 0, 1); STB2(0, bj2, n2, B2); PG8_STAGE(PG8_SA(0, 0), A2, vo); \
        PG8_WAIT_V(W2); PG8_WAIT_L(0); PG8_BAR; MMA0(1); PG8_BAR; PG8_SCHED; \
        LDB1(1, bj1, n1); PG8_SCHED; PG8_LDA(At, 1, 0); PG8_STAGE(PG8_SA(0, 1), (A2) + hstepA, vo); \
        PG8_WAIT_V(W3); PG8_WAIT_L(0); PG8_BAR; MMA1(0); PG8_BAR; PG8_SCHED; \
        PG8_LDA(At, 1, 1); STB3(1, bj3, n3, B3); PG8_STAGE(PG8_SA(1, 0), A3, vo); \
        PG8_WAIT_V(W4); PG8_WAIT_L(0); PG8_BAR; MMA1(1); PG8_BAR; PG8_SCHED;
#define F_TRIP(...) do { unsigned vo[2] = {voffA[0], voffA[1]}, vp = voffP; asm volatile("" : "+v"(vo[0]), "+v"(vo[1]), "+v"(vp));   \
        F_TRIP_BODY(__VA_ARGS__) } while (0)
#define F_TRIP_7(...) do { const unsigned vo[2] = {voffA[0], voffA[1]}; const unsigned vp = voffP; F_TRIP_BODY(__VA_ARGS__) } while (0)
#define F_TRIP_G(...) do { const unsigned vo[2] = {voffA[0], voffA[1]}; const unsigned vp = 0; (void)vp; F_TRIP_BODY(__VA_ARGS__) } while (0)
#define F_LDA_X(dst, b, h) do { _Pragma("unroll") for (int m = 0; m < 4; ++m) _Pragma("unroll") for (int k = 0; k < 2; ++k) dst[m][k] = *(const LAS bf16x8*)(lds + PG8_SA(b, h) + aoffP + m * 2048 + k * 1024); } while (0)
#define F_LDB_X(dst, b, bj, n) do { _Pragma("unroll") for (int k = 0; k < 2; ++k) dst[k] = *(const LAS bf16x8*)(lds + PG8_SB(b, bj) + boffP + (n) * 2048 + k * 1024); } while (0)
#define F_MMA_X(ai, Af, Bf) do { __builtin_amdgcn_s_setprio(1); _Pragma("unroll") for (int k = 0; k < 2; ++k) _Pragma("unroll") for (int m = 0; m < 4; ++m) \
        pacc[ai][m] = __builtin_amdgcn_mfma_f32_16x16x32_bf16(Bf[k], Af[m][k], pacc[ai][m], 0, 0, 0); __builtin_amdgcn_s_setprio(0); } while (0)
#define F_TRIP_P(bj, n, A1, STB2, bj2, n2, B2, A2, STB3, bj3, n3, B3, A3, W1, W2, W3, W4, NEXTRD) do { \
        unsigned vo[2] = {voffA[0], voffA[1]}, vp = voffP; asm volatile("" : "+v"(vo[0]), "+v"(vo[1]), "+v"(vp)); \
        F_LDB_X(Bq0, 0, bj, n); PG8_SCHED; F_LDA_X(Aq0, 0, 0); PG8_STAGE(PG8_SA(1, 1), (A1) + hstepA, vo); \
        PG8_WAIT_V(W1); PG8_WAIT_L(0); PG8_BAR; F_MMA_X(0, Aq0, Bq0); PG8_BAR; PG8_SCHED; \
        F_LDA_X(Aq0, 0, 1); STB2(0, bj2, n2, B2); PG8_STAGE(PG8_SA(0, 0), A2, vo); \
        PG8_WAIT_V(W2); PG8_WAIT_L(0); PG8_BAR; F_MMA_X(1, Aq0, Bq0); PG8_BAR; PG8_SCHED; \
        F_LDB_X(Bq0, 1, bj, n); PG8_SCHED; F_LDA_X(Aq0, 1, 0); PG8_STAGE(PG8_SA(0, 1), (A2) + hstepA, vo); \
        PG8_WAIT_V(W3); PG8_WAIT_L(0); PG8_BAR; F_MMA_X(0, Aq0, Bq0); PG8_BAR; PG8_SCHED; \
        F_LDA_X(Aq0, 1, 1); STB3(1, bj3, n3, B3); PG8_STAGE(PG8_SA(1, 0), A3, vo); \
        PG8_WAIT_V(W4); PG8_WAIT_L(0); PG8_BAR; F_MMA_X(1, Aq0, Bq0); PG8_BAR; PG8_SCHED; } while (0)
#define F_NEXT_P(bjx, nx) do { } while (0)
#define F_NEXT_NONE() do { } while (0)
#define F_UA(u) ((const char*)g.H + (size_t)(u).pm * tstep)
#define F_UB(u) ((const char*)g.WG + (size_t)(u).pn * tstep)
#define F_UY(u) ((const char*)g.Y + (size_t)(u).pm * tstep)
#define F_UW(u) ((const char*)g.WB + (size_t)(u).pn * (64 * 256 * 2))
#define F_PA(br, kt) (yA + (size_t)(((br) * 256 + (kt) * 64) * 2))
#define F_PB(br, kt) (wB + (size_t)((br) * 1024 * 256 + (kt) * 64) * 2)
#define F_FOLD() do { _Pragma("unroll") for (int ai = 0; ai < 2; ++ai) _Pragma("unroll") for (int m = 0; m < 4; ++m) { const unsigned sg = sq[0][ai][m]; \
            s[ai][m][0] += (float)(sg & 0xffu) * pacc[ai][m][0]; s[ai][m][1] += (float)((sg >> 8) & 0xffu) * pacc[ai][m][1]; \
            s[ai][m][2] += (float)((sg >> 16) & 0xffu) * pacc[ai][m][2]; s[ai][m][3] += (float)(sg >> 24) * pacc[ai][m][3]; \
            pacc[ai][m] = (f32x4){0.f, 0.f, 0.f, 0.f}; sq[0][ai][m] = sq[1][ai][m]; sq[1][ai][m] = sq[2][ai][m]; sq[2][ai][m] = sq[3][ai][m]; } } while (0)
    Unit cur, nxt; int ui = 0;
    if (!S.next(0, cur)) return;
    f32x4 acc[2][2][4][2];
#pragma unroll
    for (int a = 0; a < 2; ++a)
#pragma unroll
        for (int b = 0; b < 2; ++b)
#pragma unroll
            for (int m = 0; m < 4; ++m)
#pragma unroll
                for (int n = 0; n < 2; ++n) acc[a][b][m][n] = (f32x4){0.f, 0.f, 0.f, 0.f};
    bf16x8 At[4][2], B0[2][2], B1[2][2], Aq0[4][2], Bq0[2];
    const char* cA = F_UA(cur); const char* cB = F_UB(cur);
    PG8_STAGE(PG8_SB(0, 0), cB, voffA); PG8_STAGE(PG8_SB(0, 1), cB + hstepB, voffA); PG8_STAGE(PG8_SA(0, 0), cA, voffA); PG8_STAGE(PG8_SA(0, 1), cA + hstepA, voffA);
    if (wr == 1) PG8_BAR;
    PG8_WAIT_V(2); PG8_BAR;
    PG8_STAGE(PG8_SB(1, 0), cB + kstep, voffA); PG8_STAGE(PG8_SA(1, 0), cA + kstep, voffA); PG8_STAGE(PG8_SB(1, 1), cB + hstepB + kstep, voffA);
    PG8_WAIT_V(6); PG8_BAR;
    for (;;) {
        const bool has_next = S.next(ui + 1, nxt);
        const char* nA = has_next ? F_UA(nxt) : cA; const char* nB = has_next ? F_UB(nxt) : cB;
        const char* yA = F_UY(cur); const char* wB = F_UW(cur);
#pragma unroll 1
        for (int t = 0; t < 14; t += 2) {
            const char* a1 = cA + (size_t)(t + 1) * kstep; const char* a2 = cA + (size_t)(t + 2) * kstep; const char* b2 = cB + (size_t)(t + 2) * kstep;
            const char* a3 = a2 + kstep; const char* b3 = b2 + kstep;
            F_TRIP_G(F_LDB_G, F_MMA_G, 0, 0, F_LDB_G, F_MMA_G, 0, 0, a1, F_STB_G, 0, 0, b2, a2, F_STB_G, 0, 0, b3, a3, 8, 8, 8, 8);
        }
        unsigned voffP;
        { int ln = lane; asm volatile("" : "+v"(ln)); int R, C; stage_rc(((wid & 1) * 1024) + ln * 16, R, C); voffP = (unsigned)((16 * (wid >> 1) + (R & 15)) * 256 + C) * 2u; }
        F_TRIP_7(F_LDB_G, F_MMA_G, 0, 0, F_LDB_G, F_MMA_G, 0, 0, cA + (size_t)15 * kstep, F_STB_P, 0, 0, F_PB(0, 0), F_PA(0, 0), F_STB_P, 0, 0, F_PB(0, 1), F_PA(0, 1), 8, 5, 5, 5);
        unsigned sq[4][2][4];
#pragma unroll
        for (int ai = 0; ai < 2; ++ai)
#pragma unroll
            for (int bj = 0; bj < 2; ++bj)
#pragma unroll
                for (int m = 0; m < 4; ++m)
#pragma unroll
                    for (int n = 0; n < 2; ++n) { const f32x4 gv = acc[ai][bj][m][n]; unsigned pk = 0u;
                        pk = __builtin_amdgcn_cvt_pk_u8_f32(255.f * __builtin_amdgcn_rcpf(1.f + __expf(-gv[0])), 0, pk);
                        pk = __builtin_amdgcn_cvt_pk_u8_f32(255.f * __builtin_amdgcn_rcpf(1.f + __expf(-gv[1])), 1, pk);
                        pk = __builtin_amdgcn_cvt_pk_u8_f32(255.f * __builtin_amdgcn_rcpf(1.f + __expf(-gv[2])), 2, pk);
                        pk = __builtin_amdgcn_cvt_pk_u8_f32(255.f * __builtin_amdgcn_rcpf(1.f + __expf(-gv[3])), 3, pk);
                        sq[2 * bj + n][ai][m] = pk; }
        PG8_SCHED;
        int lnp = lane; asm volatile("" : "+v"(lnp));
        { int R, C; stage_rc(((wid & 1) * 1024) + lnp * 16, R, C); voffP = (unsigned)((16 * (wid >> 1) + (R & 15)) * 256 + C) * 2u; }
        const int frp = lnp & 15, fqp = lnp >> 4; const int aoffP = lds_byte(wr * 64 + frp, fqp * 8), boffP = lds_byte(wc * 32 + frp, fqp * 8);
        f32x4 pacc[2][4], s[2][4];
#pragma unroll
        for (int ai = 0; ai < 2; ++ai)
#pragma unroll
            for (int m = 0; m < 4; ++m) { pacc[ai][m] = (f32x4){0.f, 0.f, 0.f, 0.f}; s[ai][m] = (f32x4){0.f, 0.f, 0.f, 0.f}; }
#pragma unroll 1
        for (int br = 0; br < 3; ++br) { const int bj = br >> 1, n = br & 1, brn = br + 1, bjn = brn >> 1, nn = brn & 1;
            F_TRIP_P(bj, n, F_PA(br, 1), F_STB_P, bj, n, F_PB(br, 2), F_PA(br, 2), F_STB_P, bj, n, F_PB(br, 3), F_PA(br, 3), 5, 5, 5, 5, F_NEXT_P(bj, n));
            F_TRIP_P(bj, n, F_PA(br, 3), F_STB_P, bjn, nn, F_PB(brn, 0), F_PA(brn, 0), F_STB_P, bjn, nn, F_PB(brn, 1), F_PA(brn, 1), 5, 5, 5, 5, F_NEXT_P(bjn, nn));
            F_FOLD(); }
        F_TRIP_P(1, 1, F_PA(3, 1), F_STB_P, 1, 1, F_PB(3, 2), F_PA(3, 2), F_STB_P, 1, 1, F_PB(3, 3), F_PA(3, 3), 5, 5, 5, 5, F_NEXT_P(1, 1));
        F_TRIP_P(1, 1, F_PA(3, 3), F_STB_G, 0, 0, nB, nA, F_STB_G, 0, 0, nB + kstep, nA + kstep, 5, 8, 8, 8, F_NEXT_NONE());
        F_FOLD();
        if (wr == 0) PG8_BAR;
        { const int row0 = cur.pm * BM + wr * 64 + frp; const int oc = cur.pn * 64 + wc * 16 + 4 * fqp;
#pragma unroll
          for (int ai = 0; ai < 2; ++ai)
#pragma unroll
            for (int m = 0; m < 4; ++m) { const float q = 1.f / 255.f; u32x2 w; w.x = cvt_pk_bf16(q * s[ai][m][0], q * s[ai][m][1]); w.y = cvt_pk_bf16(q * s[ai][m][2], q * s[ai][m][3]);
                *(u32x2*)(g.O + (size_t)(row0 + ai * HALF + m * 16) * 1024 + oc) = w; } }
        if (!has_next) break;
#pragma unroll
        for (int a = 0; a < 2; ++a)
#pragma unroll
            for (int b = 0; b < 2; ++b)
#pragma unroll
                for (int m = 0; m < 4; ++m)
#pragma unroll
                    for (int n = 0; n < 2; ++n) acc[a][b][m][n] = (f32x4){0.f, 0.f, 0.f, 0.f};
        cur = nxt; cA = nA; cB = nB; ++ui;
        if (wr == 1) PG8_BAR;
    }
    PG8_WAIT_V(0);
    PG8_BAR;
#undef PG8_SA
#undef PG8_SB
#undef PG8_STAGE
#undef PG8_LDA
#undef PG8_LDB
#undef PG8_MMA
#undef PG8_WAIT_V
#undef PG8_WAIT_L
#undef PG8_BAR
#undef PG8_SCHED
}
}

struct Args { const float* in[29]; float* out; unsigned char* ws; int ph_lo, ph_hi; };

enum { I_X = 0, I_C, I_CTX, I_CCTX, I_ADAW, I_ADAB, I_WIN, I_RPB, I_GUP, I_GB, I_GNG, I_CDW, I_CB, I_CLG, I_CLB, I_SLG, I_SLB, I_SWS, I_SBS, I_WBR, I_WOUT, I_LN1G, I_LN1B, I_PWQ, I_PKEYS, I_PU, I_PV, I_LN2G, I_LN2B };

typedef const __attribute__((address_space(4))) Args* ArgsP;
struct Ctx {
    ArgsP a; LAS unsigned char* lds; unsigned char* ws;
    int tid, lane, wave, bid, nb;
};
#define WSP(T, off) ((T*)(C.ws + (off)))

__device__ __forceinline__ void phase_mod(const Ctx& C) {
    LAS float* cs = (LAS float*)C.lds;
    LAS float* red = cs + 9 * 1024;
    const float* c = C.a->in[I_C]; const float* cc = C.a->in[I_CCTX]; const float* adaw = C.a->in[I_ADAW]; const float* adab = C.a->in[I_ADAB];
    float* MOD = WSP(float, WS_MOD);
    bool loaded = false;
    for (int item = C.bid; item < 192; item += C.nb) {
        if (!loaded) { for (int i = C.tid; i < 9 * 1024; i += NT) { const int b = i >> 10, k = i & 1023; const float v = b < 8 ? c[b * 1024 + k] : cc[k]; cs[i] = siluf_(v); } __syncthreads(); loaded = true; }
        const int l = item / 96, cb = item % 96, cl = C.tid & 63, kg = C.tid >> 6;
        float acc[9];
#pragma unroll
        for (int b = 0; b < 9; ++b) acc[b] = 0.f;
        const float* w = adaw + (size_t)l * 1024 * 6144 + cb * 64 + cl;
        for (int k = kg * 128; k < kg * 128 + 128; ++k) { const float wv = w[(size_t)k * 6144];
#pragma unroll
            for (int b = 0; b < 9; ++b) acc[b] += cs[b * 1024 + k] * wv; }
#pragma unroll
        for (int b = 0; b < 9; ++b) red[(kg * 9 + b) * 64 + cl] = acc[b];
        __syncthreads();
        for (int i = C.tid; i < 576; i += NT) { const int b = i >> 6, q = i & 63; float s = 0.f;
#pragma unroll
            for (int g = 0; g < 8; ++g) s += red[(g * 9 + b) * 64 + q];
            MOD[(size_t)(l * 9 + b) * 6144 + cb * 64 + q] = s + adab[l * 6144 + cb * 64 + q]; }
        __syncthreads();
    }
}

__device__ __forceinline__ int src_col(int map, int n) {
    if (map == 0) return n;
    if (map == 1) return n < 2592 ? n : -1;
    const int pn = n >> 8, c = n & 255, bj = c >> 7, wc = (c >> 5) & 3, nn = (c >> 4) & 1, fq = (c >> 2) & 3, j = c & 3;
    return ZGATE + (2 * bj + nn) * 1024 + pn * 64 + wc * 16 + fq * 4 + j;
}
__device__ __forceinline__ void convert_item(const Ctx& C, bf16_t* dst, int K, const float* src, int ld, int map, int ir, int ik) {
    LAS float* tile = (LAS float*)C.lds;
    const int n0 = ir * 64, k0 = ik * 64;
    { const int nl = C.tid & 63, ks = C.tid >> 6; const int sc = src_col(map, n0 + nl);
#pragma unroll
      for (int it = 0; it < 8; ++it) { const int k = ks + 8 * it; tile[k * 65 + nl] = sc >= 0 ? src[(size_t)(k0 + k) * ld + sc] : 0.f; } }
    __syncthreads();
    { const int kg = C.tid & 7, n = C.tid >> 3;
      const LAS float* t8 = tile + (kg * 8) * 65 + n;
      u32x4 w; w.x = pk2(t8[0], t8[65]); w.y = pk2(t8[2 * 65], t8[3 * 65]); w.z = pk2(t8[4 * 65], t8[5 * 65]); w.w = pk2(t8[6 * 65], t8[7 * 65]);
      *(u32x4*)(dst + (size_t)(n0 + n) * K + k0 + kg * 8) = w; }
    __syncthreads();
}
__device__ __forceinline__ void phase_convert(const Ctx& C) {
    for (int item = C.bid; item < 2 * 2240; item += C.nb) {
        const int l = item / 2240; int r = item % 2240;
        unsigned char* wl = C.ws + WS_W + (size_t)l * W_LAYER;
        const float* win = C.a->in[I_WIN] + (size_t)l * 1024 * WIN_COLS;
        if (r < 704) { convert_item(C, (bf16_t*)(wl + W_WIN), 1024, win, WIN_COLS, 1, r / 16, r % 16); continue; } r -= 704;
        if (r < 1024) { convert_item(C, (bf16_t*)(wl + W_WG), 1024, win, WIN_COLS, 2, r / 16, r % 16); continue; } r -= 1024;
        if (r < 256) { const int i = r / 64, q = r % 64; convert_item(C, (bf16_t*)(wl + W_WB) + (size_t)i * 1024 * 256, 256, C.a->in[I_WBR] + (size_t)(l * 4 + i) * 256 * 1024, 1024, 0, q / 4, q % 4); continue; } r -= 256;
        convert_item(C, (bf16_t*)(wl + W_WO), 1024, C.a->in[I_WOUT] + (size_t)l * 1024 * 1024, 1024, 0, r / 16, r % 16);
    }
}
__device__ __forceinline__ void phase_fold(const Ctx& C) {
    LAS float* wqt = (LAS float*)C.lds;
    LAS float* kt = wqt + 64 * 128;
    for (int item = C.bid; item < 512; item += C.nb) {
        const int l = item >> 8, g = (item >> 4) & 15, kb = item & 15, k0 = kb * 64;
        const float* wq = C.a->in[I_PWQ] + (size_t)l * 1024 * 2048; const float* keys = C.a->in[I_PKEYS] + (size_t)(l * 16 + g) * 128 * 128;
        for (int i = C.tid; i < 64 * 128; i += NT) { const int kk = i >> 7, d = i & 127; wqt[i] = wq[(size_t)(k0 + kk) * 2048 + g * 128 + d]; }
        for (int i = C.tid; i < 128 * 128; i += NT) { const int j = i >> 7, d = i & 127; kt[j * 129 + d] = keys[i]; }
        __syncthreads();
        const int j = C.tid & 127, kq = C.tid >> 7;
        float acc[16];
#pragma unroll
        for (int i = 0; i < 16; ++i) acc[i] = 0.f;
        for (int d = 0; d < 128; ++d) { const float kv = kt[j * 129 + d];
#pragma unroll
            for (int i = 0; i < 16; ++i) acc[i] += wqt[(kq * 16 + i) * 128 + d] * kv; }
        bf16_t* dst = (bf16_t*)(C.ws + WS_W + (size_t)l * W_LAYER + W_WS) + (size_t)(g * 128 + j) * 1024 + k0 + kq * 16;
        u32x4 w0, w1; w0.x = pk2(acc[0], acc[1]); w0.y = pk2(acc[2], acc[3]); w0.z = pk2(acc[4], acc[5]); w0.w = pk2(acc[6], acc[7]);
        w1.x = pk2(acc[8], acc[9]); w1.y = pk2(acc[10], acc[11]); w1.z = pk2(acc[12], acc[13]); w1.w = pk2(acc[14], acc[15]);
        *(u32x4*)dst = w0; *(u32x4*)(dst + 8) = w1;
        __syncthreads();
    }
}
__device__ __forceinline__ void phase_h0(const Ctx& C) {
    const float* MOD = WSP(float, WS_MOD); bf16_t* H = WSP(bf16_t, WS_H);
    for (int m0 = (C.bid * 8 + C.wave) * 4; m0 < M_ALL; m0 += C.nb * 8 * 4) {
        f32x4 xv[4][4];
#pragma unroll
        for (int r = 0; r < 4; ++r) { const int m = m0 + r; const float* xr = m < M_LAT ? C.a->in[I_X] + (size_t)m * 1024 : C.a->in[I_CTX] + (size_t)(m - M_LAT) * 1024;
#pragma unroll
            for (int j = 0; j < 4; ++j) xv[r][j] = *(const f32x4*)(xr + 4 * C.lane + 256 * j); }
#pragma unroll
        for (int r = 0; r < 4; ++r) { const int m = m0 + r; const float* md = MOD + (size_t)(0 * 9 + mod_index(m)) * 6144;
#pragma unroll
            for (int j = 0; j < 4; ++j) { const int col = 4 * C.lane + 256 * j; const f32x4 sh = *(const f32x4*)(md + col), sc = *(const f32x4*)(md + 1024 + col);
                const f32x4 h = xv[r][j] * (sc + 1.f) + sh; u32x2 w; w.x = pk2(h[0], h[1]); w.y = pk2(h[2], h[3]); *(u32x2*)(H + (size_t)m * 1024 + col) = w; } }
    }
}

__device__ __forceinline__ void phase_g0(const Ctx& C, int l) {
    const bf16_t* Z = WSP(bf16_t, B_Z); float* AF = WSP(float, B_AF); float* AB = WSP(float, B_AB); bf16_t* QP = WSP(bf16_t, B_QP); bf16_t* KP = WSP(bf16_t, B_KP);
    const float* gup = C.a->in[I_GUP] + (size_t)l * 2 * 16 * 128; const float* gb = C.a->in[I_GB] + (size_t)l * 2 * 128;
    const long total = (long)M_ALL * 128;
    for (long idx = (long)C.bid * NT + C.tid; idx < total; idx += (long)C.nb * NT) {
        const int m = (int)(idx >> 7), col = (int)(idx & 127), d = col & 31;
        const bf16_t* zr = Z + (size_t)m * ZP;
        float lf = gb[col], lb = gb[128 + col];
#pragma unroll
        for (int r = 0; r < 16; ++r) { lf += bf2f(zr[ZLO + r]) * gup[r * 128 + col]; lb += bf2f(zr[ZLO + 16 + r]) * gup[(16 + r) * 128 + col]; }
        AF[idx] = (fminf(lf, 0.f) - log1pf(__expf(-fabsf(lf)))) * (1.f / 16.f);
        AB[idx] = (fminf(lb, 0.f) - log1pf(__expf(-fabsf(lb)))) * (1.f / 16.f);
        float q = bf2f(zr[ZGQ + col]) * 0.17677669529663687f, k = bf2f(zr[ZGK + col]);
        if (m < M_LAT) {
            const float qp = bf2f(zr[ZGQ + (col ^ 8)]) * 0.17677669529663687f, kp = bf2f(zr[ZGK + (col ^ 8)]);
            const int t = m & 4095, row = t >> 6, cl = t & 63; const int i = d & 7; const bool first = !(d & 8); const int pos = (d >> 4) ? cl : row;
            const float inv = __expf(-(float)i * (4.605170185988092f / 8.f));
            const float ang = (float)pos * inv; const float kk = rintf(ang * 0.15915494309189535f); const float rr = (ang - kk * 6.28125f) - kk * 1.9353071795864769e-3f; const float cs = __cosf(rr), sn = __sinf(rr);
            const float qn = first ? q * cs - qp * sn : qp * sn + q * cs; const float kn = first ? k * cs - kp * sn : kp * sn + k * cs;
            q = qn; k = kn;
        }
        QP[idx] = (bf16_t)f2bf(q); KP[idx] = (bf16_t)f2bf(k);
    }
}
__device__ __forceinline__ void phase_g1(const Ctx& C) {
    if (C.wave != 0 || C.bid >= 64) return;
    const int item = C.bid, b = item >> 3, h = (item >> 1) & 3, dir = item & 1, e = C.lane;
    const bf16_t* Z = WSP(bf16_t, B_Z); const float* LA = dir ? WSP(float, B_AB) : WSP(float, B_AF); const bf16_t* QP = WSP(bf16_t, B_QP); const bf16_t* KP = WSP(bf16_t, B_KP);
    bf16_t* O = dir ? WSP(bf16_t, B_OB) : WSP(bf16_t, B_OF);
    float s[32];
#pragma unroll
    for (int d = 0; d < 32; ++d) s[d] = 0.f;
    for (int step = 0; step < CTXL + SEQ; ++step) {
        int m;
        if (step < CTXL) { const int li = dir ? (CTXL - 1 - step) : step; m = M_LAT + b * CTXL + li; }
        else { int t = step - CTXL; if (dir) t = SEQ - 1 - t; m = b * SEQ + t; }
        const size_t o128 = (size_t)m * 128 + h * 32 + (e & 31);
        const float av = __expf(LA[o128]), kv = bf2f(KP[o128]), qv = bf2f(QP[o128]);
        const float v = bf2f(Z[(size_t)m * ZP + ZGV + h * 64 + e]);
        float o = 0.f;
#pragma unroll
        for (int d = 0; d < 32; ++d) { const float ad = rdlane(av, d), kd = rdlane(kv, d), qd = rdlane(qv, d); s[d] = ad * s[d] + kd * v; o += qd * s[d]; }
        O[(size_t)m * 256 + h * 64 + e] = (bf16_t)f2bf(o);
    }
}
__device__ __forceinline__ void phase_g2(const Ctx& C, int l) {
    const bf16_t* Z = WSP(bf16_t, B_Z); const bf16_t* OF = WSP(bf16_t, B_OF); const bf16_t* OB = WSP(bf16_t, B_OB); bf16_t* Y = WSP(bf16_t, WS_Y);
    const float* ng = C.a->in[I_GNG] + (size_t)l * 256;
    for (int m = C.bid * 8 + C.wave; m < M_ALL; m += C.nb * 8) {
        const int c0 = 4 * C.lane;
        const u32x2 a = *(const u32x2*)(OF + (size_t)m * 256 + c0), bq = *(const u32x2*)(OB + (size_t)m * 256 + c0), rr = *(const u32x2*)(Z + (size_t)m * ZP + ZGR + c0);
        float o[4] = {lo16(a.x) + lo16(bq.x), hi16(a.x) + hi16(bq.x), lo16(a.y) + lo16(bq.y), hi16(a.y) + hi16(bq.y)};
        float ss = o[0] * o[0] + o[1] * o[1] + o[2] * o[2] + o[3] * o[3];
        ss += __shfl_xor(ss, 1); ss += __shfl_xor(ss, 2); ss += __shfl_xor(ss, 4); ss += __shfl_xor(ss, 8);
        const float rs = rsqrtf(ss * (1.f / 64.f) + LN_EPS);
        const float r[4] = {lo16(rr.x), hi16(rr.x), lo16(rr.y), hi16(rr.y)};
        float y[4];
#pragma unroll
        for (int j = 0; j < 4; ++j) y[j] = o[j] * rs * ng[c0 + j] * siluf_(r[j]);
        u32x2 w; w.x = pk2(y[0], y[1]); w.y = pk2(y[2], y[3]); *(u32x2*)(Y + (size_t)m * 1024 + 256 + c0) = w;
    }
}

constexpr size_t B_U = B_OF;
constexpr size_t B_DEC = B_VN + 34 * MiB;

__device__ __forceinline__ float logsig16(float x) { return (fminf(x, 0.f) - __logf(1.f + __expf(-fabsf(x)))) * (1.f / 16.f); }

template <bool NEED_Q>
__device__ __forceinline__ void gla_prep(const Ctx& C, int l, int cid, int h, int dir, float (&b)[32], float (&q)[32], float (&k)[32]) {
    const bf16_t* Z = WSP(bf16_t, B_Z);
    const int lane = C.lane; const bf16_t* zr = Z + (size_t)(cid * 64 + lane) * ZP;
    float lo[16];
    { const u32x4* lp = (const u32x4*)(zr + ZLO + dir * 16); float t[8]; unpack8(lp[0], t);
#pragma unroll
      for (int i = 0; i < 8; ++i) lo[i] = t[i];
      unpack8(lp[1], t);
#pragma unroll
      for (int i = 0; i < 8; ++i) lo[8 + i] = t[i]; }
    const float* gup = C.a->in[I_GUP] + (size_t)((l * 2 + dir) * 16) * 128 + h * 32; const float* gb = C.a->in[I_GB] + (size_t)(l * 2 + dir) * 128 + h * 32;
    float G[8];
#pragma unroll
    for (int kk = 0; kk < 8; ++kk) { const int f = kk * 64 + lane; G[kk] = gup[(f >> 5) * 128 + (f & 31)]; }
    const float GB = gb[lane & 31];
#pragma unroll
    for (int d = 0; d < 32; ++d) { float x = rdlane(GB, d);
#pragma unroll
        for (int r = 0; r < 16; ++r) { const int f = r * 32 + d; x += lo[r] * rdlane(G[f >> 6], f & 63); }
        b[d] = logsig16(x); }
    if (dir == 0) {
#pragma unroll
        for (int off = 1; off < 64; off <<= 1) {
#pragma unroll
            for (int d = 0; d < 32; ++d) { const float t = __shfl_up(b[d], off); if (lane >= off) b[d] += t; } }
    } else {
#pragma unroll
        for (int off = 1; off < 64; off <<= 1) {
#pragma unroll
            for (int d = 0; d < 32; ++d) { const float t = __shfl_down(b[d], off); if (lane + off < 64) b[d] += t; } }
    }
    { const u32x4* kp = (const u32x4*)(zr + ZGK + h * 32);
#pragma unroll
      for (int i = 0; i < 4; ++i) unpack8(kp[i], k + 8 * i); }
    if (NEED_Q) { const u32x4* qp = (const u32x4*)(zr + ZGQ + h * 32);
#pragma unroll
      for (int i = 0; i < 4; ++i) unpack8(qp[i], q + 8 * i);
#pragma unroll
      for (int d = 0; d < 32; ++d) q[d] *= 0.17677669529663687f; }
    if (cid < 512) {
        const int row = cid & 63;
#pragma unroll
        for (int hh = 0; hh < 2; ++hh) { const float pos = (float)(hh ? lane : row);
#pragma unroll
            for (int i = 0; i < 8; ++i) { const float inv = __expf(-(float)i * (4.605170185988092f / 8.f)); const float ang = pos * inv;
                const float kk = rintf(ang * 0.15915494309189535f); const float rr = (ang - kk * 6.28125f) - kk * 1.9353071795864769e-3f; const float cs = __cosf(rr), sn = __sinf(rr);
                const int d1 = hh * 16 + i, d2 = d1 + 8;
                { const float x1 = k[d1], x2 = k[d2]; k[d1] = x1 * cs - x2 * sn; k[d2] = x1 * sn + x2 * cs; }
                if (NEED_Q) { const float x1 = q[d1], x2 = q[d2]; q[d1] = x1 * cs - x2 * sn; q[d2] = x1 * sn + x2 * cs; } } }
    }
}
__device__ __forceinline__ void phase_gla_a(const Ctx& C, int l) {
    const bf16_t* Z = WSP(bf16_t, B_Z); float* U = WSP(float, B_U); float* DEC = WSP(float, B_DEC);
    const int nw = C.nb * 8;
    for (int item = C.wave * C.nb + C.bid; item < 544 * 8; item += nw) {
        const int cid = item >> 3, h = (item >> 1) & 3, dir = item & 1, lane = C.lane;
        float b[32], k[32], qd[32];
        gla_prep<false>(C, l, cid, h, dir, b, qd, k);
        float tot[32];
#pragma unroll
        for (int d = 0; d < 32; ++d) { tot[d] = rdlane(b[d], dir ? 0 : 63); k[d] *= __expf(tot[d] - b[d]); }
        float vv[64];
        { const bf16_t* vp = Z + (size_t)(cid * 64) * ZP + ZGV + h * 64; int ln = lane; asm volatile("" : "+v"(ln));
#pragma unroll
          for (int i = 0; i < 64; ++i) vv[i] = bf2f((vp + (size_t)i * ZP)[ln]); }
        float u[32];
#pragma unroll
        for (int d = 0; d < 32; ++d) u[d] = 0.f;
#pragma unroll
        for (int i = 0; i < 64; ++i) {
#pragma unroll
            for (int d = 0; d < 32; ++d) u[d] += rdlane(k[d], i) * vv[i]; }
        const size_t off = (size_t)((cid * 4 + h) * 2 + dir);
        { float* up = U + off * 2048; int ln = lane; asm volatile("" : "+v"(ln));
#pragma unroll
          for (int d = 0; d < 32; ++d) (up + d * 64)[ln] = u[d]; }
        if (lane < 32) { float dv = 0.f;
#pragma unroll
            for (int d = 0; d < 32; ++d) dv = (lane == d) ? tot[d] : dv;
            DEC[off * 32 + lane] = __expf(dv); }
    }
}
__device__ __forceinline__ void phase_gla_scan(const Ctx& C) {
    float* U = WSP(float, B_U); const float* DEC = WSP(float, B_DEC);
    for (int idx = C.bid * NT + C.tid; idx < 64 * 2048; idx += C.nb * NT) {
        const int chain = idx >> 11, de = idx & 2047, d = de >> 6, b = chain >> 3, h = (chain >> 1) & 3, dir = chain & 1;
        float s = 0.f;
        for (int st = 0; st < 68; st += 4) {
            size_t off[4]; float tmp[4], dc[4];
#pragma unroll
            for (int j = 0; j < 4; ++j) { const int step = st + j; int cid;
                if (step < 4) cid = 512 + b * 4 + (dir ? 3 - step : step); else { const int n = step - 4; cid = b * 64 + (dir ? 63 - n : n); }
                off[j] = (size_t)((cid * 4 + h) * 2 + dir); tmp[j] = U[off[j] * 2048 + de]; dc[j] = DEC[off[j] * 32 + d]; }
#pragma unroll
            for (int j = 0; j < 4; ++j) { U[off[j] * 2048 + de] = s; s = dc[j] * s + tmp[j]; }
        }
    }
}
__device__ __forceinline__ void phase_gla_out(const Ctx& C, int l) {
    const bf16_t* Z = WSP(bf16_t, B_Z); const float* U = WSP(float, B_U); bf16_t* Y = WSP(bf16_t, WS_Y);
    const float* ng = C.a->in[I_GNG] + (size_t)l * 256;
    LAS float* o = (LAS float*)(C.lds + C.wave * 16640);
    const int nitems = (l == 0 ? 544 : 512) * 4, nw = C.nb * 8, lane = C.lane;
    for (int item = C.wave * C.nb + C.bid; item < nitems; item += nw) {
        const int cid = item >> 2, h = item & 3;
#pragma unroll 1
        for (int dir = 0; dir < 2; ++dir) {
            float b[32], qs[32], ks[32];
            gla_prep<true>(C, l, cid, h, dir, b, qs, ks);
#pragma unroll
            for (int d = 0; d < 32; ++d) { const float eb = __expf(b[d]); qs[d] *= eb; ks[d] *= __expf(-b[d]); }
            asm volatile("" ::: "memory");
            float vv[64], S[32];
            { const bf16_t* vp = Z + (size_t)(cid * 64) * ZP + ZGV + h * 64; int ln = lane; asm volatile("" : "+v"(ln));
#pragma unroll
              for (int i = 0; i < 64; ++i) vv[i] = bf2f((vp + (size_t)i * ZP)[ln]);
              const float* sp = U + (size_t)((cid * 4 + h) * 2 + dir) * 2048;
#pragma unroll
              for (int d = 0; d < 32; ++d) S[d] = (sp + d * 64)[ln]; }
#pragma unroll 1
            for (int c = 0; c < 64; ++c) {
                float a = 0.f, oc = 0.f;
#pragma unroll
                for (int d = 0; d < 32; ++d) { const float qd = rdlane(qs[d], c); a += qd * ks[d]; oc += qd * S[d]; }
                const bool ok = dir ? (lane >= c) : (lane <= c);
                a = ok ? a : 0.f;
#pragma unroll
                for (int s2 = 0; s2 < 64; ++s2) oc += rdlane(a, s2) * vv[s2];
                if (dir == 0) o[c * 65 + lane] = oc; else o[c * 65 + lane] += oc;
            }
        }
        wave_sync();
        float ss = 0.f;
#pragma unroll 8
        for (int e = 0; e < 64; ++e) { const float t = o[lane * 65 + e]; ss += t * t; }
        const float rs = rsqrtf(ss * (1.f / 64.f) + LN_EPS);
        const float g = ng[h * 64 + lane];
#pragma unroll 4
        for (int c = 0; c < 64; ++c) { const size_t m = (size_t)(cid * 64 + c);
            const float r = bf2f(Z[m * ZP + ZGR + h * 64 + lane]);
            Y[m * 1024 + 256 + h * 64 + lane] = (bf16_t)f2bf(o[c * 65 + lane] * rdlane(rs, c) * g * siluf_(r)); }
        wave_sync();
    }
}


constexpr int NA_VSTR = 136, NA_VBUF = 256 * NA_VSTR, NA_RPB_OFF = 2 * NA_VBUF;
__device__ __forceinline__ void na_vload(const bf16_t* Z, int mk0, int wave, int lane, u32x4 (&vr)[4]) {
#pragma unroll
    for (int i = 0; i < 4; ++i) { const int gidx = wave * 4 + i, key = (gidx & 3) * 16 + (lane & 15), col8 = (gidx >> 2) * 4 + (lane >> 4);
        vr[i] = *(const u32x4*)(Z + (size_t)(mk0 + key) * ZP + ZV + col8 * 8); }
}
__device__ __forceinline__ void na_vstore(LAS unsigned char* vb, int wave, int lane, const u32x4 (&vr)[4]) {
#pragma unroll
    for (int i = 0; i < 4; ++i) { const int gidx = wave * 4 + i, key = (gidx & 3) * 16 + (lane & 15), col8 = (gidx >> 2) * 4 + (lane >> 4);
        LAS unsigned char* p = vb + (col8 * 8) * NA_VSTR + key * 2;
        *(LAS bf16_t*)(p + 0 * NA_VSTR) = (bf16_t)(vr[i].x & 0xffffu); *(LAS bf16_t*)(p + 1 * NA_VSTR) = (bf16_t)(vr[i].x >> 16);
        *(LAS bf16_t*)(p + 2 * NA_VSTR) = (bf16_t)(vr[i].y & 0xffffu); *(LAS bf16_t*)(p + 3 * NA_VSTR) = (bf16_t)(vr[i].y >> 16);
        *(LAS bf16_t*)(p + 4 * NA_VSTR) = (bf16_t)(vr[i].z & 0xffffu); *(LAS bf16_t*)(p + 5 * NA_VSTR) = (bf16_t)(vr[i].z >> 16);
        *(LAS bf16_t*)(p + 6 * NA_VSTR) = (bf16_t)(vr[i].w & 0xffffu); *(LAS bf16_t*)(p + 7 * NA_VSTR) = (bf16_t)(vr[i].w >> 16); }
}
__device__ __forceinline__ void phase_na2(const Ctx& C, int l) {
    const bf16_t* Z = WSP(bf16_t, B_Z); bf16_t* Y = WSP(bf16_t, WS_Y);
    const float* rpb = C.a->in[I_RPB] + (size_t)l * 4 * 15 * 31;
    LAS float* rpbL = (LAS float*)(C.lds + NA_RPB_OFF);
    const int lane = C.lane, wave = C.wave, h = wave >> 1, qh = wave & 1, fr = lane & 15, fq = lane >> 4;
    for (int i = C.tid; i < 4 * 15 * 31; i += NT) rpbL[i] = rpb[i] * 1.4426950408889634f;
    const int nunits = (l == 0) ? 544 : 512;
    for (int ui = C.bid; ui < nunits; ui += C.nb) {
        int unit = ui;
        if (C.nb == 256 && ui < 512) unit = (C.bid & 7) * 64 + (C.bid >> 3) + 32 * (ui >> 8);
        int b, r = 0, r0 = 0, nwin, mq0;
        if (unit < 512) { b = unit >> 6; r = unit & 63; r0 = min(max(r - 4, 0), 56); nwin = 8; mq0 = b * SEQ + r * 64; }
        else { const int uc = unit - 512; b = uc >> 2; nwin = 0; mq0 = M_LAT + b * CTXL + (uc & 3) * 64; }
        const int ntile = nwin + 4;
        bf16x8 qf[2][2];
#pragma unroll
        for (int qb = 0; qb < 2; ++qb)
#pragma unroll
            for (int ks = 0; ks < 2; ++ks) qf[qb][ks] = *(const bf16x8*)(Z + (size_t)(mq0 + 32 * qh + 16 * qb + fr) * ZP + ZQ + h * 64 + ks * 32 + fq * 8);
        int c0q[2];
#pragma unroll
        for (int qb = 0; qb < 2; ++qb) c0q[qb] = min(max(32 * qh + 16 * qb + fr - 8, 0), 48);
        f32x4 ot[4][2];
#pragma unroll
        for (int db = 0; db < 4; ++db)
#pragma unroll
            for (int qb = 0; qb < 2; ++qb) ot[db][qb] = (f32x4){0.f, 0.f, 0.f, 0.f};
        float mrun[2] = {-1e30f, -1e30f}, lrun[2] = {0.f, 0.f};
        __syncthreads();
        bf16x8 kf[4][2];
        { u32x4 vr[4]; const int mk0 = nwin ? (b * SEQ + r0 * 64) : (M_LAT + b * CTXL); na_vload(Z, mk0, wave, lane, vr);
#pragma unroll
          for (int kb = 0; kb < 4; ++kb)
#pragma unroll
              for (int ks = 0; ks < 2; ++ks) kf[kb][ks] = *(const bf16x8*)(Z + (size_t)(mk0 + 16 * kb + fr) * ZP + ZK + h * 64 + ks * 32 + fq * 8);
          na_vstore(C.lds, wave, lane, vr); }
        __syncthreads();
#pragma unroll 1
        for (int t = 0; t < ntile; ++t) {
            const bool win = t < nwin;
            u32x4 vr[4];
            const int t1 = t + 1; const int mk1 = (t1 < nwin) ? (b * SEQ + (r0 + t1) * 64) : (M_LAT + b * CTXL + (t1 - nwin) * 64);
            if (t1 < ntile) na_vload(Z, mk1, wave, lane, vr);
            f32x4 st[4][2];
#pragma unroll
            for (int kb = 0; kb < 4; ++kb)
#pragma unroll
                for (int qb = 0; qb < 2; ++qb) { f32x4 a = (f32x4){0.f, 0.f, 0.f, 0.f};
#pragma unroll
                    for (int ks = 0; ks < 2; ++ks) a = __builtin_amdgcn_mfma_f32_16x16x32_bf16(kf[kb][ks], qf[qb][ks], a, 0, 0, 0);
                    st[kb][qb] = a; }
            asm volatile("" ::: "memory");
            if (t1 < ntile) {
#pragma unroll
                for (int kb = 0; kb < 4; ++kb)
#pragma unroll
                    for (int ks = 0; ks < 2; ++ks) kf[kb][ks] = *(const bf16x8*)(Z + (size_t)(mk1 + 16 * kb + fr) * ZP + ZK + h * 64 + ks * 32 + fq * 8); }
            if (win) { const LAS float* bt = rpbL + (h * 15 + (r0 + t - r + 7)) * 31 + 15;
#pragma unroll
                for (int qb = 0; qb < 2; ++qb) { const int qc = 32 * qh + 16 * qb + fr;
#pragma unroll
                    for (int kb = 0; kb < 4; ++kb)
#pragma unroll
                        for (int rg = 0; rg < 4; ++rg) { const int kc = 16 * kb + 4 * fq + rg; const bool ok = (kc >= c0q[qb]) && (kc < c0q[qb] + 16);
                            const int bi = kc - qc;
                            st[kb][qb][rg] = ok ? st[kb][qb][rg] * (0.125f * 1.4426950408889634f) + bt[bi] : -1e30f; } }
            } else {
#pragma unroll
                for (int qb = 0; qb < 2; ++qb)
#pragma unroll
                    for (int kb = 0; kb < 4; ++kb) st[kb][qb] = st[kb][qb] * (0.125f * 1.4426950408889634f);
            }
            bf16x8 pf[2][2];
#pragma unroll
            for (int qb = 0; qb < 2; ++qb) {
                float tm = -1e30f;
#pragma unroll
                for (int kb = 0; kb < 4; ++kb) tm = fmaxf(tm, fmaxf(fmaxf(st[kb][qb][0], st[kb][qb][1]), fmaxf(st[kb][qb][2], st[kb][qb][3])));
                tm = xor16_32_max(tm);
                const float mn = fmaxf(mrun[qb], tm), corr = __builtin_amdgcn_exp2f(mrun[qb] - mn); mrun[qb] = mn;
                float ps = 0.f;
#pragma unroll
                for (int kb = 0; kb < 4; ++kb)
#pragma unroll
                    for (int rg = 0; rg < 4; ++rg) { const float p = __builtin_amdgcn_exp2f(st[kb][qb][rg] - mn); st[kb][qb][rg] = p; ps += p; }
                lrun[qb] = lrun[qb] * corr + ps;
#pragma unroll
                for (int db = 0; db < 4; ++db) ot[db][qb] = ot[db][qb] * corr;
#pragma unroll
                for (int ks = 0; ks < 2; ++ks) { u32x4 w; w.x = pk2(st[2 * ks][qb][0], st[2 * ks][qb][1]); w.y = pk2(st[2 * ks][qb][2], st[2 * ks][qb][3]);
                    w.z = pk2(st[2 * ks + 1][qb][0], st[2 * ks + 1][qb][1]); w.w = pk2(st[2 * ks + 1][qb][2], st[2 * ks + 1][qb][3]); pf[qb][ks] = __builtin_bit_cast(bf16x8, w); }
            }
            const LAS unsigned char* vb = C.lds + (t & 1) * NA_VBUF + (h * 64) * NA_VSTR;
#pragma unroll
            for (int db = 0; db < 4; ++db)
#pragma unroll
                for (int ks = 0; ks < 2; ++ks) { const LAS unsigned char* vp = vb + (16 * db + fr) * NA_VSTR + (32 * ks + 4 * fq) * 2;
                    const u32x2 lo = *(const LAS u32x2*)vp, hi = *(const LAS u32x2*)(vp + 32);
                    u32x4 w; w.x = lo.x; w.y = lo.y; w.z = hi.x; w.w = hi.y; const bf16x8 vf = __builtin_bit_cast(bf16x8, w);
#pragma unroll
                    for (int qb = 0; qb < 2; ++qb) ot[db][qb] = __builtin_amdgcn_mfma_f32_16x16x32_bf16(vf, pf[qb][ks], ot[db][qb], 0, 0, 0); }
            if (t + 1 < ntile) na_vstore(C.lds + ((t + 1) & 1) * NA_VBUF, wave, lane, vr);
            __syncthreads();
        }
#pragma unroll
        for (int qb = 0; qb < 2; ++qb) { const float lt = xor16_32_sum(lrun[qb]); const float inv = __builtin_amdgcn_rcpf(lt);
            bf16_t* yp = Y + (size_t)(mq0 + 32 * qh + 16 * qb + fr) * 1024 + h * 64 + 4 * fq;
#pragma unroll
            for (int db = 0; db < 4; ++db) { u32x2 w; w.x = pk2(ot[db][qb][0] * inv, ot[db][qb][1] * inv); w.y = pk2(ot[db][qb][2] * inv, ot[db][qb][3] * inv); *(u32x2*)(yp + 16 * db) = w; } }
    }
    __syncthreads();
}


constexpr size_t WS_ROPE = 45 * MiB + 768 * 1024;
constexpr int GV_STR = 136;
constexpr int GQ_STR = 72;
__device__ __forceinline__ void phase_rope_tab(const Ctx& C) {
    float* T = WSP(float, WS_ROPE);
    for (int i = C.bid * NT + C.tid; i < 512; i += C.nb * NT) { const int pos = i >> 3, f = i & 7; const float ang = (float)pos * __expf(-(float)f * (4.605170185988092f / 8.f));
        T[2 * i] = cosf(ang); T[2 * i + 1] = sinf(ang); }
}
template <bool NEED_Q>
__device__ __forceinline__ void gla_prep2(const Ctx& C, int l, int cid, int h, int dir, float (&b)[32], float (&q)[32], float (&k)[32]) {
    const bf16_t* Z = WSP(bf16_t, B_Z);
    const int lane = C.lane; const bf16_t* zr = Z + (size_t)(cid * 64 + lane) * ZP;
    float lo[16];
    { const u32x4* lp = (const u32x4*)(zr + ZLO + dir * 16); unpack8(lp[0], lo); unpack8(lp[1], lo + 8); }
    const float* gup = C.a->in[I_GUP] + (size_t)((l * 2 + dir) * 16) * 128 + h * 32; const float* gb = C.a->in[I_GB] + (size_t)(l * 2 + dir) * 128 + h * 32;
    float G[8];
#pragma unroll
    for (int kk = 0; kk < 8; ++kk) { const int f = kk * 64 + lane; G[kk] = gup[(f >> 5) * 128 + (f & 31)]; }
    const float GB = gb[lane & 31];
#pragma unroll
    for (int d = 0; d < 32; ++d) { float x = rdlane(GB, d);
#pragma unroll
        for (int r = 0; r < 16; ++r) { const int f = r * 32 + d; x += lo[r] * rdlane(G[f >> 6], f & 63); }
        b[d] = logsig16(x); }
    if (dir == 0) {
#pragma unroll
        for (int off = 1; off < 64; off <<= 1) {
#pragma unroll
            for (int d = 0; d < 32; ++d) { const float t = __shfl_up(b[d], off); if (lane >= off) b[d] += t; } }
    } else {
#pragma unroll
        for (int off = 1; off < 64; off <<= 1) {
#pragma unroll
            for (int d = 0; d < 32; ++d) { const float t = __shfl_down(b[d], off); if (lane + off < 64) b[d] += t; } }
    }
    { const u32x4* kp = (const u32x4*)(zr + ZGK + h * 32);
#pragma unroll
      for (int i = 0; i < 4; ++i) unpack8(kp[i], k + 8 * i); }
    if (NEED_Q) { const u32x4* qp = (const u32x4*)(zr + ZGQ + h * 32);
#pragma unroll
      for (int i = 0; i < 4; ++i) unpack8(qp[i], q + 8 * i);
#pragma unroll
      for (int d = 0; d < 32; ++d) q[d] *= 0.17677669529663687f; }
    if (cid < 512) {
        const float* T = WSP(float, WS_ROPE);
#pragma unroll
        for (int hh = 0; hh < 2; ++hh) { const int pos = hh ? lane : (cid & 63); const f32x4* tp = (const f32x4*)(T + pos * 16);
#pragma unroll
            for (int i2 = 0; i2 < 4; ++i2) { const f32x4 cs2 = tp[i2];
#pragma unroll
                for (int u = 0; u < 2; ++u) { const int i = 2 * i2 + u; const float cs = cs2[2 * u], sn = cs2[2 * u + 1]; const int d1 = hh * 16 + i, d2 = d1 + 8;
                    { const float x1 = k[d1], x2 = k[d2]; k[d1] = x1 * cs - x2 * sn; k[d2] = x1 * sn + x2 * cs; }
                    if (NEED_Q) { const float x1 = q[d1], x2 = q[d2]; q[d1] = x1 * cs - x2 * sn; q[d2] = x1 * sn + x2 * cs; } } } }
    }
}
__device__ __forceinline__ void gla_stage_vT(const Ctx& C, LAS unsigned char* vT, int cid, int h) {
    const bf16_t* Z = WSP(bf16_t, B_Z); const int lane = C.lane;
    const u32x4* vp = (const u32x4*)(Z + (size_t)(cid * 64 + lane) * ZP + ZGV + h * 64);
#pragma unroll
    for (int c8 = 0; c8 < 8; ++c8) { const u32x4 w = vp[c8]; LAS unsigned char* p = vT + (c8 * 8) * GV_STR + lane * 2;
        *(LAS bf16_t*)(p + 0 * GV_STR) = (bf16_t)(w.x & 0xffffu); *(LAS bf16_t*)(p + 1 * GV_STR) = (bf16_t)(w.x >> 16); *(LAS bf16_t*)(p + 2 * GV_STR) = (bf16_t)(w.y & 0xffffu); *(LAS bf16_t*)(p + 3 * GV_STR) = (bf16_t)(w.y >> 16);
        *(LAS bf16_t*)(p + 4 * GV_STR) = (bf16_t)(w.z & 0xffffu); *(LAS bf16_t*)(p + 5 * GV_STR) = (bf16_t)(w.z >> 16); *(LAS bf16_t*)(p + 6 * GV_STR) = (bf16_t)(w.w & 0xffffu); *(LAS bf16_t*)(p + 7 * GV_STR) = (bf16_t)(w.w >> 16); }
}
__device__ __forceinline__ bf16x8 lds_frag2(const LAS unsigned char* p0, const LAS unsigned char* p1) { const u32x2 a = *(const LAS u32x2*)p0, b = *(const LAS u32x2*)p1; u32x4 w; w.x = a.x; w.y = a.y; w.z = b.x; w.w = b.y; return __builtin_bit_cast(bf16x8, w); }
__device__ __forceinline__ void phase_gla_a2(const Ctx& C, int l) {
    float* U = WSP(float, B_U); float* DEC = WSP(float, B_DEC);
    float* BF = WSP(float, B_AF); float* BB = WSP(float, B_AB); bf16_t* QP = WSP(bf16_t, B_QP); bf16_t* KP = WSP(bf16_t, B_KP);
    LAS unsigned char* vT = C.lds + C.wave * 18432; LAS unsigned char* keT = vT + 64 * GV_STR;
    const int nw = C.nb * 8, lane = C.lane, fr = lane & 15, fq = lane >> 4;
    const int w0 = C.wave * C.nb + (C.bid + C.nb - (144 % C.nb)) % C.nb;
#pragma unroll 1
    for (int pass = 0; pass < 2; ++pass) {
        int item, dlo, dhi;
        if (nw == 2048) { if (pass == 0) { item = w0; dlo = 0; dhi = 2; } else { if (w0 >= 256) break; item = 2048 + (w0 >> 1); dlo = w0 & 1; dhi = dlo + 1; } }
        else { if (pass == 1) break; item = -1; dlo = 0; dhi = 2; }
      for (int it2 = (nw == 2048 ? item : w0); it2 < 544 * 4; it2 += (nw == 2048 ? 544 * 4 : nw)) {
        const int cid = it2 >> 2, h = it2 & 3;
        gla_stage_vT(C, vT, cid, h);
#pragma unroll 1
        for (int dir = dlo; dir < dhi; ++dir) {
            const size_t ro = (size_t)(cid * 64 + lane) * 128 + h * 32;
            if (dir == 0) {
                float q[32]; const bf16_t* zr = WSP(bf16_t, B_Z) + (size_t)(cid * 64 + lane) * ZP; const u32x4* qp = (const u32x4*)(zr + ZGQ + h * 32);
#pragma unroll
                for (int i = 0; i < 4; ++i) unpack8(qp[i], q + 8 * i);
#pragma unroll
                for (int d = 0; d < 32; ++d) q[d] *= 0.17677669529663687f;
                if (cid < 512) { const float* T = WSP(float, WS_ROPE);
#pragma unroll
                    for (int hh = 0; hh < 2; ++hh) { const int pos = hh ? lane : (cid & 63); const f32x4* tp = (const f32x4*)(T + pos * 16);
#pragma unroll
                        for (int i2 = 0; i2 < 4; ++i2) { const f32x4 cs2 = tp[i2];
#pragma unroll
                            for (int u = 0; u < 2; ++u) { const int i = 2 * i2 + u; const float cs = cs2[2 * u], sn = cs2[2 * u + 1]; const int d1 = hh * 16 + i, d2 = d1 + 8;
                                const float x1 = q[d1], x2 = q[d2]; q[d1] = x1 * cs - x2 * sn; q[d2] = x1 * sn + x2 * cs; } } } }
#pragma unroll
                for (int i = 0; i < 4; ++i) { u32x4 w; w.x = pk2(q[8 * i], q[8 * i + 1]); w.y = pk2(q[8 * i + 2], q[8 * i + 3]); w.z = pk2(q[8 * i + 4], q[8 * i + 5]); w.w = pk2(q[8 * i + 6], q[8 * i + 7]); *(u32x4*)(QP + ro + 8 * i) = w; }
                asm volatile("" ::: "memory");
            }
            float b[32], k[32], qdummy[32];
            gla_prep2<false>(C, l, cid, h, dir, b, qdummy, k);
            { float* bp = (dir ? BB : BF) + ro;
#pragma unroll
              for (int i = 0; i < 8; ++i) *(f32x4*)(bp + 4 * i) = (f32x4){b[4 * i], b[4 * i + 1], b[4 * i + 2], b[4 * i + 3]}; }
            if (dir == 0) {
#pragma unroll
                for (int i = 0; i < 4; ++i) { u32x4 x; x.x = pk2(k[8 * i], k[8 * i + 1]); x.y = pk2(k[8 * i + 2], k[8 * i + 3]); x.z = pk2(k[8 * i + 4], k[8 * i + 5]); x.w = pk2(k[8 * i + 6], k[8 * i + 7]); *(u32x4*)(KP + ro + 8 * i) = x; } }
            float tot[32];
#pragma unroll
            for (int d = 0; d < 32; ++d) { tot[d] = rdlane(b[d], dir ? 0 : 63); *(LAS bf16_t*)(keT + d * GV_STR + lane * 2) = (bf16_t)f2bf(k[d] * __expf(tot[d] - b[d])); }
            wave_sync();
            f32x4 acc[4][2];
#pragma unroll
            for (int eb = 0; eb < 4; ++eb)
#pragma unroll
                for (int db = 0; db < 2; ++db) acc[eb][db] = (f32x4){0.f, 0.f, 0.f, 0.f};
#pragma unroll
            for (int ks = 0; ks < 2; ++ks) { bf16x8 vf[4], kf[2];
#pragma unroll
                for (int eb = 0; eb < 4; ++eb) { const LAS unsigned char* p = vT + (16 * eb + fr) * GV_STR + (32 * ks + 8 * fq) * 2; vf[eb] = lds_frag2(p, p + 8); }
#pragma unroll
                for (int db = 0; db < 2; ++db) { const LAS unsigned char* p = keT + (16 * db + fr) * GV_STR + (32 * ks + 8 * fq) * 2; kf[db] = lds_frag2(p, p + 8); }
#pragma unroll
                for (int eb = 0; eb < 4; ++eb)
#pragma unroll
                    for (int db = 0; db < 2; ++db) acc[eb][db] = __builtin_amdgcn_mfma_f32_16x16x32_bf16(kf[db], vf[eb], acc[eb][db], 0, 0, 0); }
            const size_t off = (size_t)((cid * 4 + h) * 2 + dir);
#pragma unroll
            for (int eb = 0; eb < 4; ++eb)
#pragma unroll
                for (int db = 0; db < 2; ++db)
                    *(f32x4*)(U + off * 2048 + (16 * eb + fr) * 32 + 16 * db + 4 * fq) = acc[eb][db];
            if (lane < 32) { float dv = 0.f;
#pragma unroll
                for (int d = 0; d < 32; ++d) dv = (lane == d) ? tot[d] : dv;
                DEC[off * 32 + lane] = __expf(dv); }
            wave_sync();
        }
      }
    }
}
__device__ __forceinline__ void phase_gla_scan2(const Ctx& C) {
    float* U = WSP(float, B_U); const float* DEC = WSP(float, B_DEC);
    for (int idx = C.bid * NT + C.tid; idx < 64 * 2048; idx += C.nb * NT) {
        const int chain = idx >> 11, de = idx & 2047, d = de & 31, b = chain >> 3, h = (chain >> 1) & 3, dir = chain & 1;
        float s = 0.f;
        for (int st = 0; st < 68; st += 17) {
            size_t off[17]; float tmp[17], dc[17];
#pragma unroll
            for (int j = 0; j < 17; ++j) { const int step = st + j; int cid;
                if (step < 4) cid = 512 + b * 4 + (dir ? 3 - step : step); else { const int n = step - 4; cid = b * 64 + (dir ? 63 - n : n); }
                off[j] = (size_t)((cid * 4 + h) * 2 + dir); tmp[j] = U[off[j] * 2048 + de]; dc[j] = DEC[off[j] * 32 + d]; }
#pragma unroll
            for (int j = 0; j < 17; ++j) { U[off[j] * 2048 + de] = s; s = dc[j] * s + tmp[j]; }
        }
    }
}
__device__ __forceinline__ void phase_gla_out2(const Ctx& C, int l) {
    const bf16_t* Z = WSP(bf16_t, B_Z); const float* U = WSP(float, B_U); bf16_t* Y = WSP(bf16_t, WS_Y);
    const float* BF = WSP(float, B_AF); const float* BB = WSP(float, B_AB); const bf16_t* QP = WSP(bf16_t, B_QP); const bf16_t* KP = WSP(bf16_t, B_KP);
    const float* ng = C.a->in[I_GNG] + (size_t)l * 256;
    LAS unsigned char* vT = C.lds + C.wave * 18432; LAS unsigned char* qsR = vT + 64 * GV_STR; LAS unsigned char* ksR = qsR + 64 * GQ_STR;
    const int nitems = (l == 0 ? 544 : 512) * 4, nw = C.nb * 8, lane = C.lane, fr = lane & 15, fq = lane >> 4;
    const int w0 = C.wave * C.nb + C.bid; const bool split = (nw == 2048) && (nitems > nw);
#pragma unroll 1
    for (int pass = 0; ; ++pass) {
        int it, cb0 = 0, cb1 = 4;
        if (split) { if (pass == 0) it = w0; else if (pass == 1 && w0 < 256) { it = 2048 + (w0 >> 1); cb0 = (w0 & 1) * 2; cb1 = cb0 + 2; } else break; }
        else { it = w0 + pass * nw; if (it >= nitems) break; }
        const int cid = it >> 2, h = it & 3;
        gla_stage_vT(C, vT, cid, h);
        f32x4 oT[4][4];
#pragma unroll
        for (int eb = 0; eb < 4; ++eb)
#pragma unroll
            for (int cb = 0; cb < 4; ++cb) oT[eb][cb] = (f32x4){0.f, 0.f, 0.f, 0.f};
#pragma unroll 1
        for (int dir = 0; dir < 2; ++dir) {
            {
                const size_t ro = (size_t)(cid * 64 + lane) * 128 + h * 32; const float* bp = (dir ? BB : BF) + ro;
#pragma unroll
                for (int i = 0; i < 4; ++i) { const f32x4 b0 = *(const f32x4*)(bp + 8 * i), b1 = *(const f32x4*)(bp + 8 * i + 4); const u32x4 qw = *(const u32x4*)(QP + ro + 8 * i), kw = *(const u32x4*)(KP + ro + 8 * i);
                    float qv[8], kv[8], eb8[8]; unpack8(qw, qv); unpack8(kw, kv);
#pragma unroll
                    for (int j = 0; j < 4; ++j) { eb8[j] = __expf(b0[j]); eb8[4 + j] = __expf(b1[j]); }
                    u32x2 w0, w1, x0, x1;
                    w0.x = pk2(qv[0] * eb8[0], qv[1] * eb8[1]); w0.y = pk2(qv[2] * eb8[2], qv[3] * eb8[3]); w1.x = pk2(qv[4] * eb8[4], qv[5] * eb8[5]); w1.y = pk2(qv[6] * eb8[6], qv[7] * eb8[7]);
                    x0.x = pk2(kv[0] * __builtin_amdgcn_rcpf(eb8[0]), kv[1] * __builtin_amdgcn_rcpf(eb8[1])); x0.y = pk2(kv[2] * __builtin_amdgcn_rcpf(eb8[2]), kv[3] * __builtin_amdgcn_rcpf(eb8[3]));
                    x1.x = pk2(kv[4] * __builtin_amdgcn_rcpf(eb8[4]), kv[5] * __builtin_amdgcn_rcpf(eb8[5])); x1.y = pk2(kv[6] * __builtin_amdgcn_rcpf(eb8[6]), kv[7] * __builtin_amdgcn_rcpf(eb8[7]));
                    *(LAS u32x2*)(qsR + lane * GQ_STR + 16 * i) = w0; *(LAS u32x2*)(qsR + lane * GQ_STR + 16 * i + 8) = w1;
                    *(LAS u32x2*)(ksR + lane * GQ_STR + 16 * i) = x0; *(LAS u32x2*)(ksR + lane * GQ_STR + 16 * i + 8) = x1; }
            }
            wave_sync();
            bf16x8 vf[4][2], sf[4];
#pragma unroll
            for (int eb = 0; eb < 4; ++eb) {
#pragma unroll
                for (int ks = 0; ks < 2; ++ks) { const LAS unsigned char* p = vT + (16 * eb + fr) * GV_STR + (32 * ks + 4 * fq) * 2; vf[eb][ks] = lds_frag2(p, p + 32); }
                const float* sp = U + (size_t)((cid * 4 + h) * 2 + dir) * 2048 + (16 * eb + fr) * 32 + 8 * fq; const f32x4 s0 = *(const f32x4*)sp, s1 = *(const f32x4*)(sp + 4);
                u32x4 w; w.x = pk2(s0[0], s0[1]); w.y = pk2(s0[2], s0[3]); w.z = pk2(s1[0], s1[1]); w.w = pk2(s1[2], s1[3]); sf[eb] = __builtin_bit_cast(bf16x8, w); }
            bf16x8 kfr[4];
#pragma unroll
            for (int sb = 0; sb < 4; ++sb) { const LAS unsigned char* p = ksR + (16 * sb + fr) * GQ_STR + 16 * fq; kfr[sb] = lds_frag2(p, p + 8); }
#pragma unroll
            for (int cb = 0; cb < 4; ++cb) { if (cb < cb0 || cb >= cb1) continue;
                const LAS unsigned char* p = qsR + (16 * cb + fr) * GQ_STR + 16 * fq; const bf16x8 qf = lds_frag2(p, p + 8);
                f32x4 at[4];
#pragma unroll
                for (int sb = 0; sb < 4; ++sb) { at[sb] = __builtin_amdgcn_mfma_f32_16x16x32_bf16(kfr[sb], qf, (f32x4){0.f, 0.f, 0.f, 0.f}, 0, 0, 0);
#pragma unroll
                    for (int rg = 0; rg < 4; ++rg) { const int sI = 16 * sb + 4 * fq + rg, cI = 16 * cb + fr; const bool ok = dir ? (sI >= cI) : (sI <= cI); at[sb][rg] = ok ? at[sb][rg] : 0.f; } }
#pragma unroll
                for (int ks = 0; ks < 2; ++ks) { u32x4 w; w.x = pk2(at[2 * ks][0], at[2 * ks][1]); w.y = pk2(at[2 * ks][2], at[2 * ks][3]); w.z = pk2(at[2 * ks + 1][0], at[2 * ks + 1][1]); w.w = pk2(at[2 * ks + 1][2], at[2 * ks + 1][3]);
                    const bf16x8 pf = __builtin_bit_cast(bf16x8, w);
#pragma unroll
                    for (int eb = 0; eb < 4; ++eb) oT[eb][cb] = __builtin_amdgcn_mfma_f32_16x16x32_bf16(vf[eb][ks], pf, oT[eb][cb], 0, 0, 0); }
#pragma unroll
                for (int eb = 0; eb < 4; ++eb) oT[eb][cb] = __builtin_amdgcn_mfma_f32_16x16x32_bf16(sf[eb], qf, oT[eb][cb], 0, 0, 0);
            }
            wave_sync();
        }
#pragma unroll
        for (int cb = 0; cb < 4; ++cb) { if (cb < cb0 || cb >= cb1) continue; float ss = 0.f;
#pragma unroll
            for (int eb = 0; eb < 4; ++eb) ss += (oT[eb][cb][0] * oT[eb][cb][0] + oT[eb][cb][1] * oT[eb][cb][1]) + (oT[eb][cb][2] * oT[eb][cb][2] + oT[eb][cb][3] * oT[eb][cb][3]);
            ss = xor16_32_sum(ss);
            const float rs = rsqrtf(ss * (1.f / 64.f) + LN_EPS);
            const size_t m = (size_t)(cid * 64 + 16 * cb + fr);
#pragma unroll
            for (int eb = 0; eb < 4; ++eb) { const int e0 = h * 64 + 16 * eb + 4 * fq; const u32x2 rr = *(const u32x2*)(Z + m * ZP + ZGR + e0); const f32x4 g4 = *(const f32x4*)(ng + e0);
                const float y0 = oT[eb][cb][0] * rs * g4[0] * siluf_(lo16(rr.x)), y1 = oT[eb][cb][1] * rs * g4[1] * siluf_(hi16(rr.x)), y2 = oT[eb][cb][2] * rs * g4[2] * siluf_(lo16(rr.y)), y3 = oT[eb][cb][3] * rs * g4[3] * siluf_(hi16(rr.y));
                u32x2 w; w.x = pk2(y0, y1); w.y = pk2(y2, y3); *(u32x2*)(Y + m * 1024 + 256 + e0) = w; } }
    }
}

__device__ __forceinline__ void phase_na(const Ctx& C, int l) {
    const bf16_t* Z = WSP(bf16_t, B_Z); bf16_t* Y = WSP(bf16_t, WS_Y);
    const float* rpb = C.a->in[I_RPB] + (size_t)l * 4 * 15 * 31;
    const int total = 4 * M_ALL;
    for (int idx = C.bid * NT + C.tid; idx < total; idx += C.nb * NT) {
        const int h = idx / M_ALL, m = idx % M_ALL;
        float q[64], acc[64];
        { const u32x4* qp = (const u32x4*)(Z + (size_t)m * ZP + ZQ + h * 64);
#pragma unroll
          for (int i = 0; i < 8; ++i) { const u32x4 v = qp[i]; q[8 * i + 0] = lo16(v.x) * 0.125f; q[8 * i + 1] = hi16(v.x) * 0.125f; q[8 * i + 2] = lo16(v.y) * 0.125f; q[8 * i + 3] = hi16(v.y) * 0.125f;
              q[8 * i + 4] = lo16(v.z) * 0.125f; q[8 * i + 5] = hi16(v.z) * 0.125f; q[8 * i + 6] = lo16(v.w) * 0.125f; q[8 * i + 7] = hi16(v.w) * 0.125f; } }
#pragma unroll
        for (int i = 0; i < 64; ++i) acc[i] = 0.f;
        float mx = -1e30f, den = 0.f;
        int b, nwin = 0, r = 0, cq = 0, r0 = 0, c0 = 0;
        if (m < M_LAT) { b = m >> 12; const int t = m & 4095; r = t >> 6; cq = t & 63; r0 = min(max(r - 4, 0), 56); c0 = min(max(cq - 8, 0), 48); nwin = 128; }
        else b = (m - M_LAT) >> 8;
        for (int kk = 0; kk < nwin + CTXL; ++kk) {
            int mk; float bias = 0.f;
            if (kk < nwin) { const int kr = r0 + (kk >> 4), kc = c0 + (kk & 15); mk = b * SEQ + kr * 64 + kc; bias = rpb[(h * 15 + (kr - r + 7)) * 31 + (kc - cq + 15)]; }
            else mk = M_LAT + b * CTXL + (kk - nwin);
            const u32x4* kp = (const u32x4*)(Z + (size_t)mk * ZP + ZK + h * 64);
            float s = 0.f;
#pragma unroll
            for (int i = 0; i < 8; ++i) { const u32x4 v = kp[i]; s += q[8 * i + 0] * lo16(v.x) + q[8 * i + 1] * hi16(v.x) + q[8 * i + 2] * lo16(v.y) + q[8 * i + 3] * hi16(v.y)
                  + q[8 * i + 4] * lo16(v.z) + q[8 * i + 5] * hi16(v.z) + q[8 * i + 6] * lo16(v.w) + q[8 * i + 7] * hi16(v.w); }
            s += bias;
            const float mn = fmaxf(mx, s), corr = __expf(mx - mn), p = __expf(s - mn);
            den = den * corr + p; mx = mn;
            const u32x4* vp = (const u32x4*)(Z + (size_t)mk * ZP + ZV + h * 64);
#pragma unroll
            for (int i = 0; i < 8; ++i) { const u32x4 v = vp[i];
                acc[8 * i + 0] = acc[8 * i + 0] * corr + p * lo16(v.x); acc[8 * i + 1] = acc[8 * i + 1] * corr + p * hi16(v.x); acc[8 * i + 2] = acc[8 * i + 2] * corr + p * lo16(v.y); acc[8 * i + 3] = acc[8 * i + 3] * corr + p * hi16(v.y);
                acc[8 * i + 4] = acc[8 * i + 4] * corr + p * lo16(v.z); acc[8 * i + 5] = acc[8 * i + 5] * corr + p * hi16(v.z); acc[8 * i + 6] = acc[8 * i + 6] * corr + p * lo16(v.w); acc[8 * i + 7] = acc[8 * i + 7] * corr + p * hi16(v.w); }
        }
        const float inv = 1.f / den;
        u32x4* yp = (u32x4*)(Y + (size_t)m * 1024 + h * 64);
#pragma unroll
        for (int i = 0; i < 8; ++i) { u32x4 w; w.x = pk2(acc[8 * i] * inv, acc[8 * i + 1] * inv); w.y = pk2(acc[8 * i + 2] * inv, acc[8 * i + 3] * inv); w.z = pk2(acc[8 * i + 4] * inv, acc[8 * i + 5] * inv); w.w = pk2(acc[8 * i + 6] * inv, acc[8 * i + 7] * inv); yp[i] = w; }
    }
}
__device__ __forceinline__ void phase_conv(const Ctx& C, int l) {
    const bf16_t* Z = WSP(bf16_t, B_Z); bf16_t* Y = WSP(bf16_t, WS_Y);
    const float* dw = C.a->in[I_CDW] + (size_t)l * 31 * 256; const float* cb = C.a->in[I_CB] + l * 256; const float* lg = C.a->in[I_CLG] + l * 256; const float* lb = C.a->in[I_CLB] + l * 256;
    for (int m = C.bid * 8 + C.wave; m < M_ALL; m += C.nb * 8) {
        int base, pos, len;
        if (m < M_LAT) { base = m & ~4095; pos = m & 4095; len = SEQ; } else { base = M_LAT + ((m - M_LAT) & ~255); pos = (m - M_LAT) & 255; len = CTXL; }
        float y[4];
#pragma unroll
        for (int i = 0; i < 4; ++i) y[i] = cb[C.lane + 64 * i];
        for (int j = 0; j < 31; ++j) { const int p = pos + j - 15; if (p < 0 || p >= len) continue;
            const bf16_t* zr = Z + (size_t)(base + p) * ZP;
#pragma unroll
            for (int i = 0; i < 4; ++i) { const int ch = C.lane + 64 * i; const float a = bf2f(zr[ZCA + ch]), g = bf2f(zr[ZCG + ch]); y[i] += dw[j * 256 + ch] * a * sigmoidf_(g); } }
        const float mu = wave_sum(y[0] + y[1] + y[2] + y[3]) * (1.f / 256.f);
        float q = 0.f;
#pragma unroll
        for (int i = 0; i < 4; ++i) { y[i] -= mu; q += y[i] * y[i]; }
        const float rs = rsqrtf(wave_sum(q) * (1.f / 256.f) + LN_EPS);
#pragma unroll
        for (int i = 0; i < 4; ++i) { const int ch = C.lane + 64 * i; const float v = y[i] * rs * lg[ch] + lb[ch]; Y[(size_t)m * 1024 + 512 + ch] = (bf16_t)f2bf(siluf_(v)); }
    }
}

__device__ __forceinline__ void conv_unit(int unit, int& base, int& p0, int& len) {
    if (unit < 1024) { base = (unit >> 7) * SEQ; p0 = (unit & 127) * 32; len = SEQ; } else { const int uc = unit - 1024; base = M_LAT + (uc >> 3) * CTXL; p0 = (uc & 7) * 32; len = CTXL; }
}
__device__ __forceinline__ void phase_conv2(const Ctx& C, int l) {
    const bf16_t* Z = WSP(bf16_t, B_Z); bf16_t* Y = WSP(bf16_t, WS_Y);
    const float* dw = C.a->in[I_CDW] + (size_t)l * 31 * 256; const float* cb = C.a->in[I_CB] + l * 256; const float* lg = C.a->in[I_CLG] + l * 256; const float* lb = C.a->in[I_CLB] + l * 256;
    LAS float* tile = (LAS float*)C.lds;
    LAS float* co = (LAS float*)(C.lds + 65536);
    const int nunits = (l == 0) ? 1088 : 1024;
    const int ch = C.tid & 255, hf = C.tid >> 8;
    float w[31];
#pragma unroll
    for (int j = 0; j < 31; ++j) w[j] = dw[j * 256 + ch];
    const float bias = cb[ch];
    const f32x4 gg = *(const f32x4*)(lg + 4 * C.lane), bb = *(const f32x4*)(lb + 4 * C.lane);
    int unit = (C.bid + C.nb - (64 % C.nb)) % C.nb;
    if (unit >= nunits) return;
    u32x4 av[4], gv[4];
    { int base, p0, len; conv_unit(unit, base, p0, len);
#pragma unroll
      for (int i = 0; i < 4; ++i) { const int c = C.tid + i * NT; const int rr = min(c >> 5, 61), c8 = (c & 31) * 8; const int p = min(max(p0 - 15 + rr, 0), len - 1);
          const bf16_t* zr = Z + (size_t)(base + p) * ZP; av[i] = *(const u32x4*)(zr + ZCA + c8); gv[i] = *(const u32x4*)(zr + ZCG + c8); } }
#pragma unroll 1
    for (;;) {
        int base, p0, len; conv_unit(unit, base, p0, len);
#pragma unroll
        for (int i = 0; i < 4; ++i) { const int c = C.tid + i * NT; const int rr = c >> 5, c8 = (c & 31) * 8; const int p = p0 - 15 + rr; const bool ok = p >= 0 && p < len;
            const u32x4 a = av[i], g = gv[i]; f32x4 o0, o1;
            o0[0] = lo16(a.x) * sigmoidf_(lo16(g.x)); o0[1] = hi16(a.x) * sigmoidf_(hi16(g.x)); o0[2] = lo16(a.y) * sigmoidf_(lo16(g.y)); o0[3] = hi16(a.y) * sigmoidf_(hi16(g.y));
            o1[0] = lo16(a.z) * sigmoidf_(lo16(g.z)); o1[1] = hi16(a.z) * sigmoidf_(hi16(g.z)); o1[2] = lo16(a.w) * sigmoidf_(lo16(g.w)); o1[3] = hi16(a.w) * sigmoidf_(hi16(g.w));
            if (!ok) { o0 = (f32x4){0.f, 0.f, 0.f, 0.f}; o1 = o0; }
            if (c < 62 * 32) { *(LAS f32x4*)(tile + rr * 256 + c8) = o0; *(LAS f32x4*)(tile + rr * 256 + c8 + 4) = o1; } }
        __syncthreads();
        const int nxt = unit + C.nb; const bool more = nxt < nunits;
        { int nb_, np0, nlen; conv_unit(more ? nxt : unit, nb_, np0, nlen);
#pragma unroll
          for (int i = 0; i < 4; ++i) { const int c = C.tid + i * NT; const int rr = min(c >> 5, 61), c8 = (c & 31) * 8; const int p = min(max(np0 - 15 + rr, 0), nlen - 1);
              const bf16_t* zr = Z + (size_t)(nb_ + p) * ZP; av[i] = *(const u32x4*)(zr + ZCA + c8); gv[i] = *(const u32x4*)(zr + ZCG + c8); } }
        { float in[46];
#pragma unroll
          for (int i = 0; i < 46; ++i) in[i] = tile[(hf * 16 + i) * 256 + ch];
#pragma unroll
          for (int o = 0; o < 16; ++o) { float y = bias;
#pragma unroll
              for (int j = 0; j < 31; ++j) y += w[j] * in[o + j];
              co[(hf * 16 + o) * 256 + ch] = y; } }
        __syncthreads();
#pragma unroll
        for (int k = 0; k < 4; ++k) { const int tk = C.wave * 4 + k; const int c0 = 4 * C.lane;
            f32x4 y = *(const LAS f32x4*)(co + tk * 256 + c0);
            const float mu = wave_sum((y[0] + y[1]) + (y[2] + y[3])) * (1.f / 256.f);
            y = y - mu;
            const float rs = rsqrtf(wave_sum((y[0] * y[0] + y[1] * y[1]) + (y[2] * y[2] + y[3] * y[3])) * (1.f / 256.f) + LN_EPS);
            float o[4];
#pragma unroll
            for (int i = 0; i < 4; ++i) o[i] = siluf_(y[i] * rs * gg[i] + bb[i]);
            u32x2 wv; wv.x = pk2(o[0], o[1]); wv.y = pk2(o[2], o[3]); *(u32x2*)(Y + (size_t)(base + p0 + tk) * 1024 + 512 + c0) = wv; }
        __syncthreads();
        if (!more) break;
        unit = nxt;
    }
}

__device__ __forceinline__ void phase_sgu1(const Ctx& C, int l) {
    const bf16_t* Z = WSP(bf16_t, B_Z); float* VN = WSP(float, B_VN);
    const float* lg = C.a->in[I_SLG] + l * 256; const float* lb = C.a->in[I_SLB] + l * 256;
    for (int m = C.bid * 8 + C.wave; m < M_ALL; m += C.nb * 8) {
        const int c0 = 4 * C.lane; const u32x2 zz = *(const u32x2*)(Z + (size_t)m * ZP + ZSV + c0);
        float v[4] = {gelu_tanh(lo16(zz.x)), gelu_tanh(hi16(zz.x)), gelu_tanh(lo16(zz.y)), gelu_tanh(hi16(zz.y))};
        const float mu = wave_sum(v[0] + v[1] + v[2] + v[3]) * (1.f / 256.f);
        float q = 0.f;
#pragma unroll
        for (int i = 0; i < 4; ++i) { v[i] -= mu; q += v[i] * v[i]; }
        const float rs = rsqrtf(wave_sum(q) * (1.f / 256.f) + LN_EPS);
        f32x4 o;
#pragma unroll
        for (int i = 0; i < 4; ++i) o[i] = v[i] * rs * lg[c0 + i] + lb[c0 + i];
        *(f32x4*)(VN + (size_t)m * 256 + c0) = o;
    }
}
__device__ __forceinline__ void phase_sgu2(const Ctx& C, int l) {
    const bf16_t* Z = WSP(bf16_t, B_Z); const float* VN = WSP(float, B_VN); bf16_t* Y = WSP(bf16_t, WS_Y);
    const float* ws = C.a->in[I_SWS] + (size_t)l * 4 * 128 * 128; const float* bs = C.a->in[I_SBS] + (size_t)l * 4 * 128;
    const long total = (long)M_ALL * 256;
    for (long idx = (long)C.bid * NT + C.tid; idx < total; idx += (long)C.nb * NT) {
        const int m = (int)(idx >> 8), ch = (int)(idx & 255), g = ch >> 6, p = m & 127, mb = m & ~127;
        const float* wr = ws + (size_t)(g * 128 + p) * 128; const float* vb = VN + (size_t)mb * 256 + ch;
        float s = bs[g * 128 + p];
#pragma unroll 8
        for (int q = 0; q < 128; ++q) s += wr[q] * vb[(size_t)q * 256];
        const float u = gelu_tanh(bf2f(Z[(size_t)m * ZP + ZSU + ch]));
        Y[(size_t)m * 1024 + 768 + ch] = (bf16_t)f2bf(u * s);
    }
}


constexpr size_t WS_WSB = 45 * MiB;
constexpr int VT_STRIDE = 272;
__device__ __forceinline__ void phase_wsb(const Ctx& C) {
    const float* ws = C.a->in[I_SWS]; bf16_t* d = WSP(bf16_t, WS_WSB);
    for (int i = C.bid * NT + C.tid; i < 2 * 4 * 128 * 128; i += C.nb * NT) { d[i] = (bf16_t)f2bf(ws[i]); asm volatile("" : "+v"(i)); }
}
__device__ __forceinline__ void phase_sgu(const Ctx& C, int l) {
    const bf16_t* Z = WSP(bf16_t, B_Z); bf16_t* Y = WSP(bf16_t, WS_Y);
    const float* lg = C.a->in[I_SLG] + l * 256; const float* lb = C.a->in[I_SLB] + l * 256; const float* bs = C.a->in[I_SBS] + (size_t)l * 4 * 128;
    const bf16_t* wsb = WSP(bf16_t, WS_WSB) + (size_t)l * 4 * 128 * 128;
    const int nunits = (l == 0) ? 272 : 256, lane = C.lane, wave = C.wave;
    const int rot = (C.bid + C.nb - (128 % C.nb)) % C.nb; const bool split = (C.nb == 256) && (nunits > 256);
#pragma unroll 1
    for (int pass = 0; ; ++pass) {
        int unit, pb0 = 0, pb1 = 8;
        if (split) { if (pass == 0) unit = rot; else if (pass == 1 && rot < 64) { unit = 256 + (rot >> 2); pb0 = (rot & 3) * 2; pb1 = pb0 + 2; } else break; }
        else { unit = rot + pass * C.nb; if (unit >= nunits) break; }
        const int mb = unit * 128;
        u32x2 zn[4];
#pragma unroll
        for (int r = 0; r < 4; ++r) zn[r] = *(const u32x2*)(Z + (size_t)(mb + wave * 16 + r) * ZP + ZSV + 4 * lane);
#pragma unroll 1
        for (int rr = 0; rr < 16; rr += 4) { const int c0 = 4 * lane; u32x2 zz[4];
#pragma unroll
            for (int r = 0; r < 4; ++r) zz[r] = zn[r];
            { const int rn = (rr + 4 < 16) ? rr + 4 : rr;
#pragma unroll
              for (int r = 0; r < 4; ++r) zn[r] = *(const u32x2*)(Z + (size_t)(mb + wave * 16 + rn + r) * ZP + ZSV + c0); }
            float v[4][4], mu[4], qq[4];
#pragma unroll
            for (int r = 0; r < 4; ++r) { v[r][0] = gelu_tanh(lo16(zz[r].x)); v[r][1] = gelu_tanh(hi16(zz[r].x)); v[r][2] = gelu_tanh(lo16(zz[r].y)); v[r][3] = gelu_tanh(hi16(zz[r].y)); mu[r] = (v[r][0] + v[r][1]) + (v[r][2] + v[r][3]); }
#pragma unroll
            for (int r = 0; r < 4; ++r) mu[r] = wave_sum(mu[r]);
#pragma unroll
            for (int r = 0; r < 4; ++r) { mu[r] *= (1.f / 256.f); qq[r] = 0.f;
#pragma unroll
                for (int i = 0; i < 4; ++i) { v[r][i] -= mu[r]; qq[r] += v[r][i] * v[r][i]; } }
#pragma unroll
            for (int r = 0; r < 4; ++r) qq[r] = wave_sum(qq[r]);
#pragma unroll
            for (int r = 0; r < 4; ++r) { const int q = wave * 16 + rr + r; const float rs = rsqrtf(qq[r] * (1.f / 256.f) + LN_EPS);
#pragma unroll
                for (int i = 0; i < 4; ++i) { const float o = v[r][i] * rs * lg[c0 + i] + lb[c0 + i]; *(LAS bf16_t*)(C.lds + (c0 + i) * VT_STRIDE + q * 2) = (bf16_t)f2bf(o); } } }
        __syncthreads();
        const int g = wave >> 1, cbase = g * 64 + (wave & 1) * 32, fr = lane & 15, fq = lane >> 4;
        if (pb1 - pb0 == 8) {
        f32x4 acc[2][8];
#pragma unroll
        for (int cb = 0; cb < 2; ++cb)
#pragma unroll
            for (int pb = 0; pb < 8; ++pb) acc[cb][pb] = (f32x4){0.f, 0.f, 0.f, 0.f};
#pragma unroll
        for (int ks = 0; ks < 4; ++ks) {
            bf16x8 af[2], bfr[8];
#pragma unroll
            for (int cb = 0; cb < 2; ++cb) af[cb] = *(const LAS bf16x8*)(C.lds + (cbase + cb * 16 + fr) * VT_STRIDE + (ks * 32 + fq * 8) * 2);
#pragma unroll
            for (int pb = 0; pb < 8; ++pb) bfr[pb] = *(const bf16x8*)(wsb + (size_t)(g * 128 + pb * 16 + fr) * 128 + ks * 32 + fq * 8);
#pragma unroll
            for (int cb = 0; cb < 2; ++cb)
#pragma unroll
                for (int pb = 0; pb < 8; ++pb) acc[cb][pb] = __builtin_amdgcn_mfma_f32_16x16x32_bf16(af[cb], bfr[pb], acc[cb][pb], 0, 0, 0);
        }
#pragma unroll
        for (int pb = 0; pb < 8; ++pb) { const int p = pb * 16 + fr; const float bsv = bs[g * 128 + p];
#pragma unroll
            for (int cb = 0; cb < 2; ++cb) { const int c = cbase + cb * 16 + 4 * fq;
                const u32x2 uu = *(const u32x2*)(Z + (size_t)(mb + p) * ZP + ZSU + c);
                const float y0 = gelu_tanh(lo16(uu.x)) * (acc[cb][pb][0] + bsv), y1 = gelu_tanh(hi16(uu.x)) * (acc[cb][pb][1] + bsv), y2 = gelu_tanh(lo16(uu.y)) * (acc[cb][pb][2] + bsv), y3 = gelu_tanh(hi16(uu.y)) * (acc[cb][pb][3] + bsv);
                u32x2 w; w.x = pk2(y0, y1); w.y = pk2(y2, y3); *(u32x2*)(Y + (size_t)(mb + p) * 1024 + 768 + c) = w; } }
        } else {
#pragma unroll 1
            for (int pb = pb0; pb < pb1; ++pb) {
                f32x4 a2[2] = {(f32x4){0.f, 0.f, 0.f, 0.f}, (f32x4){0.f, 0.f, 0.f, 0.f}};
#pragma unroll
                for (int ks = 0; ks < 4; ++ks) { const bf16x8 bq = *(const bf16x8*)(wsb + (size_t)(g * 128 + pb * 16 + fr) * 128 + ks * 32 + fq * 8);
#pragma unroll
                    for (int cb = 0; cb < 2; ++cb) { const bf16x8 aq = *(const LAS bf16x8*)(C.lds + (cbase + cb * 16 + fr) * VT_STRIDE + (ks * 32 + fq * 8) * 2);
                        a2[cb] = __builtin_amdgcn_mfma_f32_16x16x32_bf16(aq, bq, a2[cb], 0, 0, 0); } }
                const int p = pb * 16 + fr; const float bsv = bs[g * 128 + p];
#pragma unroll
                for (int cb = 0; cb < 2; ++cb) { const int c = cbase + cb * 16 + 4 * fq;
                    const u32x2 uu = *(const u32x2*)(Z + (size_t)(mb + p) * ZP + ZSU + c);
                    const float y0 = gelu_tanh(lo16(uu.x)) * (a2[cb][0] + bsv), y1 = gelu_tanh(hi16(uu.x)) * (a2[cb][1] + bsv), y2 = gelu_tanh(lo16(uu.y)) * (a2[cb][2] + bsv), y3 = gelu_tanh(hi16(uu.y)) * (a2[cb][3] + bsv);
                    u32x2 w; w.x = pk2(y0, y1); w.y = pk2(y2, y3); *(u32x2*)(Y + (size_t)(mb + p) * 1024 + 768 + c) = w; } }
        }
        __syncthreads();
    }
}

__device__ __forceinline__ float* xrow_out(const Ctx& C, int m) { return m < M_LAT ? C.a->out + (size_t)m * 1024 : WSP(float, WS_XC) + (size_t)(m - M_LAT) * 1024; }
__device__ __forceinline__ bf16_t* xb_row(const Ctx& C, int m) { return WSP(bf16_t, WS_Y) + (size_t)m * 1024; }
__device__ __forceinline__ bf16_t* xd_row(const Ctx& C, int m) { return (bf16_t*)C.a->out + (size_t)m * 1024; }
__device__ __forceinline__ const float* xrow_in(const Ctx& C, int l, int m) {
    if (l == 0) return m < M_LAT ? C.a->in[I_X] + (size_t)m * 1024 : C.a->in[I_CTX] + (size_t)(m - M_LAT) * 1024;
    return xrow_out(C, m);
}
__device__ __forceinline__ void phase_ln1(const Ctx& C, int l) {
    const float* MOD = WSP(float, WS_MOD); bf16_t* H = WSP(bf16_t, WS_H);
    const float* g_ = C.a->in[I_LN1G] + l * 1024; const float* b_ = C.a->in[I_LN1B] + l * 1024;
    const int mrows = (l == 0) ? M_ALL : M_LAT;
    for (int m0 = (C.bid * 8 + C.wave) * 4; m0 < mrows; m0 += C.nb * 8 * 4) {
        f32x4 xv[4][4]; u32x2 yv[4][4];
#pragma unroll
        for (int r = 0; r < 4; ++r)
#pragma unroll
            for (int j = 0; j < 4; ++j) yv[r][j] = __builtin_nontemporal_load((const u32x2*)(H + (size_t)(m0 + r) * 1024 + 4 * C.lane + 256 * j));
        if (l == 0) {
#pragma unroll
            for (int r = 0; r < 4; ++r) { const float* xr = xrow_in(C, 0, m0 + r);
#pragma unroll
                for (int j = 0; j < 4; ++j) xv[r][j] = __builtin_nontemporal_load((const f32x4*)(xr + 4 * C.lane + 256 * j)); }
        } else { u32x2 xx[4][4];
#pragma unroll
            for (int r = 0; r < 4; ++r) { const bf16_t* xd = xd_row(C, m0 + r);
#pragma unroll
                for (int j = 0; j < 4; ++j) xx[r][j] = __builtin_nontemporal_load((const u32x2*)(xd + 4 * C.lane + 256 * j)); }
#pragma unroll
            for (int r = 0; r < 4; ++r)
#pragma unroll
                for (int j = 0; j < 4; ++j) { xv[r][j][0] = lo16(xx[r][j].x); xv[r][j][1] = hi16(xx[r][j].x); xv[r][j][2] = lo16(xx[r][j].y); xv[r][j][3] = hi16(xx[r][j].y); } }
#pragma unroll
        for (int r = 0; r < 4; ++r) { const int m = m0 + r; bf16_t* xo = xb_row(C, m);
            const float* md = MOD + (size_t)(l * 9 + mod_index(m)) * 6144;
            f32x4 v[4]; float s = 0.f;
#pragma unroll
            for (int j = 0; j < 4; ++j) { const int col = 4 * C.lane + 256 * j; const f32x4 g1 = *(const f32x4*)(md + 2048 + col); const u32x2 yy = yv[r][j];
                f32x4 y; y[0] = lo16(yy.x); y[1] = hi16(yy.x); y[2] = lo16(yy.y); y[3] = hi16(yy.y);
                v[j] = xv[r][j] * ALPHA + g1 * y; s += (v[j][0] + v[j][1]) + (v[j][2] + v[j][3]); }
            const float mu = wave_sum(s) * (1.f / 1024.f); float q = 0.f;
#pragma unroll
            for (int j = 0; j < 4; ++j) { v[j] = v[j] - mu; q += (v[j][0] * v[j][0] + v[j][1] * v[j][1]) + (v[j][2] * v[j][2] + v[j][3] * v[j][3]); }
            const float rs = rsqrtf(wave_sum(q) * (1.f / 1024.f) + LN_EPS);
#pragma unroll
            for (int j = 0; j < 4; ++j) { const int col = 4 * C.lane + 256 * j; const f32x4 x1 = v[j] * rs * *(const f32x4*)(g_ + col) + *(const f32x4*)(b_ + col);
                { u32x2 wx; wx.x = pk2(x1[0], x1[1]); wx.y = pk2(x1[2], x1[3]); *(u32x2*)(xo + col) = wx; }
                const f32x4 h2 = x1 * (*(const f32x4*)(md + 4096 + col) + 1.f) + *(const f32x4*)(md + 3072 + col);
                u32x2 w; w.x = pk2(h2[0], h2[1]); w.y = pk2(h2[2], h2[3]); *(u32x2*)(H + (size_t)m * 1024 + col) = w; } }
    }
}
__device__ __forceinline__ void phase_tables(const Ctx& C, int l) {
    const f32x4* su = (const f32x4*)(C.a->in[I_PU] + (size_t)l * 16384 * 1024); const f32x4* sv = (const f32x4*)(C.a->in[I_PV] + (size_t)l * 16384 * 1024);
    u32x2* du = WSP(u32x2, B_TU); u32x2* dv = WSP(u32x2, B_TV);
    const long n4 = (long)16384 * 1024 / 4;
    for (long i = (long)C.bid * NT + C.tid; i < n4; i += (long)C.nb * NT) {
        const f32x4 a = su[i], b = sv[i]; u32x2 wa, wb; wa.x = pk2(a[0], a[1]); wa.y = pk2(a[2], a[3]); wb.x = pk2(b[0], b[1]); wb.y = pk2(b[2], b[3]); du[i] = wa; dv[i] = wb; }
}
__device__ const unsigned char PAIR_TAB[64] = {0,1,2,3,4,5,6,7,8,9,10,11,12,13,14,15,16,17,18,19,20,21,22,23,32,33,34,35,36,48,49,50,51,64,65,66,80,81,96,97,112,113,128,144,160,176,192,208,224,240, 0,0,0,0,0,0,0,0,0,0,0,0,0,0};
__device__ __forceinline__ unsigned ord16(unsigned h) { return (h & 0x8000u) ? (~h & 0xffffu) : (h | 0x8000u); }
__device__ __forceinline__ float dec16(unsigned key) { const unsigned o = key >> 7; const unsigned short h = (unsigned short)((o & 0x8000u) ? (o & 0x7fffu) : (~o & 0xffffu)); return (float)__builtin_bit_cast(_Float16, h); }
__device__ __forceinline__ unsigned ordf(float f) { const unsigned u = __float_as_uint(f); return (u & 0x80000000u) ? ~u : (u | 0x80000000u); }


__device__ __forceinline__ void phase_peer(const Ctx& C, int l) {
    const float* MOD = WSP(float, WS_MOD); bf16_t* H = WSP(bf16_t, WS_H); const unsigned short* S = WSP(unsigned short, B_S);
    const bf16_t* TU = WSP(bf16_t, B_TU); const bf16_t* TV = WSP(bf16_t, B_TV);
    const float* g_ = C.a->in[I_LN2G] + l * 1024; const float* b_ = C.a->in[I_LN2B] + l * 1024;
    LAS unsigned* scr = (LAS unsigned*)(C.lds + C.wave * 2048);
    LAS unsigned* skey = scr;
    LAS unsigned* top = scr + 128;
    LAS unsigned* ckey = scr + 160;
    LAS int* sel_e = (LAS int*)(scr + 224);
    LAS float* sel_s = (LAS float*)(scr + 240);
    const int lane = C.lane;
    for (int m = C.bid * 8 + C.wave; m < M_ALL; m += C.nb * 8) {
        float hv[16], out[16];
        { const u32x4* hp = (const u32x4*)(H + (size_t)m * 1024); unpack8(hp[lane], hv); unpack8(hp[64 + lane], hv + 8); }
#pragma unroll
        for (int i = 0; i < 16; ++i) out[i] = 0.f;
        const unsigned short* srow = S + (size_t)m * 2048;
        for (int h = 0; h < 8; ++h) {
#pragma unroll 1
            for (int side = 0; side < 2; ++side) {
                const unsigned short* sp = srow + (h * 2 + side) * 128;
                const unsigned k0 = (ord16(sp[lane]) << 7) | (unsigned)(127 - lane), k1 = (ord16(sp[lane + 64]) << 7) | (unsigned)(63 - lane);
                skey[lane] = k0; skey[lane + 64] = k1; wave_sync();
                int r0 = 0, r1 = 0;
#pragma unroll 8
                for (int y = 0; y < 128; ++y) { const unsigned kk = skey[y]; r0 += kk > k0 ? 1 : 0; r1 += kk > k1 ? 1 : 0; }
                if (r0 < 16) top[side * 16 + r0] = k0;
                if (r1 < 16) top[side * 16 + r1] = k1;
                wave_sync();
            }
            const int pij = PAIR_TAB[lane], pi = pij >> 4, pj = pij & 15;
            const unsigned ka = top[pi], kb = top[16 + pj];
            const float cs = dec16(ka) + dec16(kb);
            const unsigned ck = lane < 50 ? ((ordf(cs) & ~255u) | (unsigned)(255 - pij)) : 0u;
            ckey[lane] = ck; wave_sync();
            int r = 0;
#pragma unroll 8
            for (int y = 0; y < 64; ++y) r += ckey[y] > ck ? 1 : 0;
            if (lane < 50 && r < 16) { sel_e[r] = (int)((127u - (ka & 127u)) * 128u + (127u - (kb & 127u))); sel_s[r] = cs; }
            wave_sync();
            const float sv = sel_s[lane & 15], smax = sel_s[0];
            const float ex = __expf(sv - smax); float den = ex; den += __shfl_xor(den, 1); den += __shfl_xor(den, 2); den += __shfl_xor(den, 4); den += __shfl_xor(den, 8);
            const float gk = ex / den;
            const int ek = sel_e[lane & 15];
#pragma unroll 1
            for (int half = 0; half < 2; ++half) {
                u32x4 ua[8], ub[8], va[8], vb[8];
#pragma unroll
                for (int i = 0; i < 8; ++i) { const int e = __builtin_amdgcn_readlane(ek, half * 8 + i);
                    const u32x4* up = (const u32x4*)(TU + (size_t)e * 1024); const u32x4* vp = (const u32x4*)(TV + (size_t)e * 1024);
                    ua[i] = up[lane]; ub[i] = up[64 + lane]; va[i] = vp[lane]; vb[i] = vp[64 + lane]; }
#pragma unroll
                for (int i = 0; i < 8; ++i) { float t[16]; unpack8(ua[i], t); unpack8(ub[i], t + 8); float p = 0.f;
#pragma unroll
                    for (int j = 0; j < 16; ++j) p += hv[j] * t[j];
                    p = wave_sum(p);
                    const float w = rdlane(gk, half * 8 + i) * gelu_tanh(p);
                    unpack8(va[i], t); unpack8(vb[i], t + 8);
#pragma unroll
                    for (int j = 0; j < 16; ++j) out[j] += w * t[j]; }
            }
            wave_sync();
        }
        const float* xr = xrow_out(C, m); float* xo = xrow_out(C, m);
        const float* md = MOD + (size_t)(l * 9 + mod_index(m)) * 6144;
        float v[16]; float s = 0.f;
#pragma unroll
        for (int hh = 0; hh < 2; ++hh)
#pragma unroll
            for (int q4 = 0; q4 < 2; ++q4) { const int col = hh * 512 + 8 * lane + 4 * q4; const f32x4 x = *(const f32x4*)(xr + col), g2 = *(const f32x4*)(md + 5120 + col);
#pragma unroll
                for (int j = 0; j < 4; ++j) { const float t = ALPHA * x[j] + g2[j] * out[hh * 8 + q4 * 4 + j]; v[hh * 8 + q4 * 4 + j] = t; s += t; } }
        const float mu = wave_sum(s) * (1.f / 1024.f); float q = 0.f;
#pragma unroll
        for (int j = 0; j < 16; ++j) { v[j] -= mu; q += v[j] * v[j]; }
        const float rs = rsqrtf(wave_sum(q) * (1.f / 1024.f) + LN_EPS);
        const float* mdn = MOD + (size_t)((l + 1) * 9 + mod_index(m)) * 6144;
#pragma unroll
        for (int hh = 0; hh < 2; ++hh) { float hn[8];
#pragma unroll
            for (int q4 = 0; q4 < 2; ++q4) { const int col = hh * 512 + 8 * lane + 4 * q4; const f32x4 gg = *(const f32x4*)(g_ + col), bb = *(const f32x4*)(b_ + col); f32x4 x2;
#pragma unroll
                for (int j = 0; j < 4; ++j) x2[j] = v[hh * 8 + q4 * 4 + j] * rs * gg[j] + bb[j];
                *(f32x4*)(xo + col) = x2;
                if (l == 0) { const f32x4 sh = *(const f32x4*)(mdn + col), sc = *(const f32x4*)(mdn + 1024 + col);
#pragma unroll
                    for (int j = 0; j < 4; ++j) hn[q4 * 4 + j] = x2[j] * (1.f + sc[j]) + sh[j]; } }
            if (l == 0) { u32x4 w; w.x = pk2(hn[0], hn[1]); w.y = pk2(hn[2], hn[3]); w.z = pk2(hn[4], hn[5]); w.w = pk2(hn[6], hn[7]); ((u32x4*)(H + (size_t)m * 1024))[hh * 64 + lane] = w; } }
    }
}


constexpr int PG_STRIDE = 272;
__device__ __forceinline__ void ins16(unsigned (&list)[16], unsigned x) {
#pragma unroll
    for (int p = 0; p < 16; ++p) { const unsigned t = max(list[p], x); x = min(list[p], x); list[p] = t; }
}

__device__ __forceinline__ void ce_u32(unsigned& a, unsigned& b, bool desc) { const unsigned hi = max(a, b), lo = min(a, b); a = desc ? hi : lo; b = desc ? lo : hi; }
__device__ __forceinline__ void sort16_desc(unsigned (&a)[16]) {
#pragma unroll
    for (int k = 2; k <= 16; k <<= 1)
#pragma unroll
        for (int j = k >> 1; j >= 1; j >>= 1)
#pragma unroll
            for (int i = 0; i < 16; ++i) { const int l = i ^ j; if (l > i) ce_u32(a[i], a[l], (i & k) == 0); }
}
__device__ __forceinline__ void merge16_desc(unsigned (&top)[16], const unsigned (&nw)[16]) {
#pragma unroll
    for (int i = 0; i < 16; ++i) top[i] = max(top[i], nw[15 - i]);
#pragma unroll
    for (int j = 8; j >= 1; j >>= 1)
#pragma unroll
        for (int i = 0; i < 16; ++i) { const int l = i ^ j; if (l > i) ce_u32(top[i], top[l], true); }
}
__device__ __forceinline__ unsigned key_h(unsigned h, int idx) { const unsigned m = (unsigned)((int)(h << 16) >> 31); const unsigned o = (h ^ ((m & 0x7fffu) | 0x8000u)) & 0xffffu; return (o << 7) | (unsigned)(127 - idx); }
__device__ __forceinline__ float reduce8(const float (&p)[8], int lane) {
    float q[4], r[2];
#pragma unroll
    for (int i = 0; i < 4; ++i) { const auto x = __builtin_amdgcn_permlane32_swap(__float_as_uint(p[i]), __float_as_uint(p[4 + i]), false, false); q[i] = __uint_as_float(x[0]) + __uint_as_float(x[1]); }
#pragma unroll
    for (int i = 0; i < 2; ++i) { const auto x = __builtin_amdgcn_permlane16_swap(__float_as_uint(q[i]), __float_as_uint(q[2 + i]), false, false); r[i] = __uint_as_float(x[0]) + __uint_as_float(x[1]); }
    float t; { const bool hi = lane & 8; const float send = hi ? r[0] : r[1], keep = hi ? r[1] : r[0]; t = keep + __int_as_float(__builtin_amdgcn_update_dpp(0, __float_as_int(send), 0x128, 0xF, 0xF, false)); }
    t += __int_as_float(__builtin_amdgcn_update_dpp(0, __float_as_int(t), 0xB1, 0xF, 0xF, false));
    t += __int_as_float(__builtin_amdgcn_update_dpp(0, __float_as_int(t), 0x4E, 0xF, 0xF, false));
    t += __int_as_float(__builtin_amdgcn_update_dpp(0, __float_as_int(t), 0x141, 0xF, 0xF, false));
    return t;
}
__device__ __forceinline__ void peer_token(const Ctx& C, int l, int m, int tl) {
    const float* MOD = WSP(float, WS_MOD); bf16_t* H = WSP(bf16_t, WS_H);
    const bf16_t* TU = WSP(bf16_t, B_TU); const bf16_t* TV = WSP(bf16_t, B_TV);
    const float* g_ = C.a->in[I_LN2G] + l * 1024; const float* b_ = C.a->in[I_LN2B] + l * 1024;
    const int lane = C.lane;
    float hv[16], out[16];
    { const u32x4* hp = (const u32x4*)(H + (size_t)m * 1024); unpack8(hp[lane], hv); unpack8(hp[64 + lane], hv + 8); }
#pragma unroll
    for (int i = 0; i < 16; ++i) out[i] = 0.f;
#pragma unroll 1
    for (int h = 0; h < 8; ++h) {
        const LAS unsigned char* rA = C.lds + (tl * 16 + 2 * h) * PG_STRIDE;
        const int ek = *(const LAS int*)(rA + 4 * (lane & 15)); const float gk = *(const LAS float*)(rA + PG_STRIDE + 4 * (lane & 15));
#pragma unroll 1
        for (int half = 0; half < 2; ++half) {
            u32x4 ua[8], ub[8], va[8], vb[8];
#pragma unroll
            for (int i = 0; i < 8; ++i) { const int e = __builtin_amdgcn_readlane(ek, half * 8 + i);
                const u32x4* up = (const u32x4*)(TU + (size_t)e * 1024); const u32x4* vp = (const u32x4*)(TV + (size_t)e * 1024);
                ua[i] = up[lane]; ub[i] = up[64 + lane]; va[i] = vp[lane]; vb[i] = vp[64 + lane]; }
            float p[8];
#pragma unroll
            for (int i = 0; i < 8; ++i) { float t[16]; unpack8(ua[i], t); unpack8(ub[i], t + 8); float a = 0.f;
#pragma unroll
                for (int j = 0; j < 16; ++j) a += hv[j] * t[j];
                p[i] = a; }
            const float tsum = reduce8(p, lane);
#pragma unroll
            for (int i = 0; i < 8; ++i) { const float dot = rdlane(tsum, (i >> 2) * 32 + ((i >> 1) & 1) * 16 + (i & 1) * 8);
                const float w = rdlane(gk, half * 8 + i) * gelu_tanh(dot);
                float t[16]; unpack8(va[i], t); unpack8(vb[i], t + 8);
#pragma unroll
                for (int j = 0; j < 16; ++j) out[j] += w * t[j]; }
        }
    }
    float* xo = xrow_out(C, m); const float* xr = xo;
    const float* md = MOD + (size_t)(l * 9 + mod_index(m)) * 6144;
    float v[16]; float s = 0.f;
#pragma unroll
    for (int hh = 0; hh < 2; ++hh)
#pragma unroll
        for (int q4 = 0; q4 < 2; ++q4) { const int col = hh * 512 + 8 * lane + 4 * q4; const f32x4 x = *(const f32x4*)(xr + col), g2 = *(const f32x4*)(md + 5120 + col);
#pragma unroll
            for (int j = 0; j < 4; ++j) { const float t = ALPHA * x[j] + g2[j] * out[hh * 8 + q4 * 4 + j]; v[hh * 8 + q4 * 4 + j] = t; s += t; } }
    const float mu = wave_sum(s) * (1.f / 1024.f); float q = 0.f;
#pragma unroll
    for (int j = 0; j < 16; ++j) { v[j] -= mu; q += v[j] * v[j]; }
    const float rs = rsqrtf(wave_sum(q) * (1.f / 1024.f) + LN_EPS);
    const float* mdn = MOD + (size_t)((l + 1) * 9 + mod_index(m)) * 6144;
#pragma unroll
    for (int hh = 0; hh < 2; ++hh) { float hn[8];
#pragma unroll
        for (int q4 = 0; q4 < 2; ++q4) { const int col = hh * 512 + 8 * lane + 4 * q4; const f32x4 gg = *(const f32x4*)(g_ + col), bb = *(const f32x4*)(b_ + col); f32x4 x2;
#pragma unroll
            for (int j = 0; j < 4; ++j) x2[j] = v[hh * 8 + q4 * 4 + j] * rs * gg[j] + bb[j];
            *(f32x4*)(xo + col) = x2;
            if (l == 0) { const f32x4 sh = *(const f32x4*)(mdn + col), sc = *(const f32x4*)(mdn + 1024 + col);
#pragma unroll
                for (int j = 0; j < 4; ++j) hn[q4 * 4 + j] = x2[j] * (1.f + sc[j]) + sh[j]; } }
        if (l == 0) { u32x4 w; w.x = pk2(hn[0], hn[1]); w.y = pk2(hn[2], hn[3]); w.z = pk2(hn[4], hn[5]); w.w = pk2(hn[6], hn[7]); ((u32x4*)(H + (size_t)m * 1024))[hh * 64 + lane] = w; } }
}

constexpr float TU_SCALE = 256.f, TV_SCALE = 16.f;
__device__ __forceinline__ void phase_tables8(const Ctx& C, int l) {
    const f32x4* su = (const f32x4*)(C.a->in[I_PU] + (size_t)l * 16384 * 1024); const f32x4* sv = (const f32x4*)(C.a->in[I_PV] + (size_t)l * 16384 * 1024);
    u32x4* du = WSP(u32x4, B_TU); u32x4* dv = WSP(u32x4, B_TV);
    const long n16 = (long)16384 * 1024 / 16;
    for (long i = (long)C.bid * NT + C.tid; i < n16; i += (long)C.nb * NT) {
        u32x4 wa, wb;
#pragma unroll
        for (int k = 0; k < 4; ++k) { const f32x4 a = su[4 * i + k] * TU_SCALE, b = sv[4 * i + k] * TV_SCALE; unsigned x = 0u, y = 0u;
            x = __builtin_amdgcn_cvt_pk_fp8_f32(a[0], a[1], x, false); x = __builtin_amdgcn_cvt_pk_fp8_f32(a[2], a[3], x, true);
            y = __builtin_amdgcn_cvt_pk_fp8_f32(b[0], b[1], y, false); y = __builtin_amdgcn_cvt_pk_fp8_f32(b[2], b[3], y, true);
            wa[k] = x; wb[k] = y; }
        du[i] = wa; dv[i] = wb; }
}
__device__ __forceinline__ void unpack16_fp8(const u32x4 v, float* o) {
#pragma unroll
    for (int k = 0; k < 4; ++k) { const f32x2 lo = __builtin_amdgcn_cvt_pk_f32_fp8((int)v[k], false), hi = __builtin_amdgcn_cvt_pk_f32_fp8((int)v[k], true); o[4 * k] = lo.x; o[4 * k + 1] = lo.y; o[4 * k + 2] = hi.x; o[4 * k + 3] = hi.y; }
}
__device__ __forceinline__ void peer_token8(const Ctx& C, int l, int m, int tl, bool dry) {
    const float* MOD = WSP(float, WS_MOD); bf16_t* H = WSP(bf16_t, WS_H);
    const unsigned char* TU = WSP(unsigned char, B_TU); const unsigned char* TV = WSP(unsigned char, B_TV);
    const float* g_ = C.a->in[I_LN2G] + l * 1024; const float* b_ = C.a->in[I_LN2B] + l * 1024;
    const int lane = C.lane;
    float hv[16], out[16];
    { const u32x4* hp = (const u32x4*)(H + (size_t)m * 1024); unpack8(hp[2 * lane], hv); unpack8(hp[2 * lane + 1], hv + 8); }
#pragma unroll
    for (int i = 0; i < 16; ++i) out[i] = 0.f;
#pragma unroll 1
    for (int h = 0; h < 8; ++h) {
        const LAS unsigned char* rA = C.lds + (tl * 16 + 2 * h) * PG_STRIDE;
        const int ek = *(const LAS int*)(rA + 4 * (lane & 15)); const float gk = *(const LAS float*)(rA + PG_STRIDE + 4 * (lane & 15));
#pragma unroll 1
        for (int half = 0; half < 2; ++half) {
            u32x4 ur[8], vr[8];
#pragma unroll
            for (int i = 0; i < 8; ++i) { const int e = __builtin_amdgcn_readlane(ek, half * 8 + i); ur[i] = ((const u32x4*)(TU + (size_t)e * 1024))[lane]; vr[i] = ((const u32x4*)(TV + (size_t)e * 1024))[lane]; }
            __builtin_amdgcn_sched_barrier(0);
            float p[8];
#pragma unroll
            for (int i = 0; i < 8; ++i) { float t[16]; unpack16_fp8(ur[i], t); float a = 0.f;
#pragma unroll
                for (int j = 0; j < 16; ++j) a += hv[j] * t[j];
                p[i] = a; __builtin_amdgcn_sched_barrier(0); }
            const float tsum = reduce8(p, lane);
#pragma unroll
            for (int i = 0; i < 8; ++i) { const float dot = rdlane(tsum, (i >> 2) * 32 + ((i >> 1) & 1) * 16 + (i & 1) * 8) * (1.f / TU_SCALE);
                const float w = rdlane(gk, half * 8 + i) * gelu_tanh(dot) * (1.f / TV_SCALE);
                float t[16]; unpack16_fp8(vr[i], t);
#pragma unroll
                for (int j = 0; j < 16; ++j) out[j] += w * t[j];
                __builtin_amdgcn_sched_barrier(0); }
        }
    }
    float* xo = xrow_out(C, m); float* xw = dry ? WSP(float, B_VN) + (size_t)(C.bid * 8 + C.wave) * 1024 : xo; bf16_t* hw = dry ? WSP(bf16_t, B_VN + 16 * MiB) + (size_t)(C.bid * 8 + C.wave) * 1024 : H + (size_t)m * 1024;
    const float* md = MOD + (size_t)(l * 9 + mod_index(m)) * 6144;
    float v[16]; float s = 0.f;
#pragma unroll
    for (int q4 = 0; q4 < 4; ++q4) { const int col = 16 * lane + 4 * q4; const f32x4 x = *(const f32x4*)(xo + col), g2 = *(const f32x4*)(md + 5120 + col);
#pragma unroll
        for (int j = 0; j < 4; ++j) { const float t = ALPHA * x[j] + g2[j] * out[q4 * 4 + j]; v[q4 * 4 + j] = t; s += t; } }
    const float mu = wave_sum(s) * (1.f / 1024.f); float q = 0.f;
#pragma unroll
    for (int j = 0; j < 16; ++j) { v[j] -= mu; q += v[j] * v[j]; }
    const float rs = rsqrtf(wave_sum(q) * (1.f / 1024.f) + LN_EPS);
    const float* mdn = MOD + (size_t)((l + 1) * 9 + mod_index(m)) * 6144;
    float hn[16];
#pragma unroll
    for (int q4 = 0; q4 < 4; ++q4) { const int col = 16 * lane + 4 * q4; const f32x4 gg = *(const f32x4*)(g_ + col), bb = *(const f32x4*)(b_ + col); f32x4 x2;
#pragma unroll
        for (int j = 0; j < 4; ++j) x2[j] = v[q4 * 4 + j] * rs * gg[j] + bb[j];
        *(f32x4*)(xw + col) = x2;
        if (l == 0) { const f32x4 sh = *(const f32x4*)(mdn + col), sc = *(const f32x4*)(mdn + 1024 + col);
#pragma unroll
            for (int j = 0; j < 4; ++j) hn[q4 * 4 + j] = x2[j] * (1.f + sc[j]) + sh[j]; } }
    if (l == 0) { u32x4 w0, w1; w0.x = pk2(hn[0], hn[1]); w0.y = pk2(hn[2], hn[3]); w0.z = pk2(hn[4], hn[5]); w0.w = pk2(hn[6], hn[7]);
        w1.x = pk2(hn[8], hn[9]); w1.y = pk2(hn[10], hn[11]); w1.z = pk2(hn[12], hn[13]); w1.w = pk2(hn[14], hn[15]);
        u32x4* hp = (u32x4*)hw; hp[2 * lane] = w0; hp[2 * lane + 1] = w1; }
}


typedef float v32f __attribute__((ext_vector_type(32)));
typedef float v16f __attribute__((ext_vector_type(16)));
typedef int v6i __attribute__((ext_vector_type(6)));
constexpr float T6U = 48.f, T6V = 3.f;

__device__ __forceinline__ unsigned fp6_enc(float a) {
    const unsigned sg = (__float_as_uint(a) >> 31) << 5; const float m = fminf(fabsf(a), 7.5f);
    unsigned code;
    if (m < 1.f) code = (unsigned)rintf(m * 8.f);
    else { const int e = (m >= 4.f) ? 3 : ((m >= 2.f) ? 2 : 1); const float inv = (e == 3) ? 2.f : ((e == 2) ? 4.f : 8.f); code = (unsigned)((e - 1) * 8) + (unsigned)rintf(m * inv); }
    code = min(code, 31u);
    return sg | code;
}
__device__ __forceinline__ void fp6_pack16(const float* x, float scale, unsigned (&d)[3]) {
    unsigned long long lo = 0ull; unsigned hi = 0u;
#pragma unroll
    for (int k = 0; k < 16; ++k) { const unsigned long long f = fp6_enc(x[k] * scale); const int bit = 6 * k;
        if (bit < 64) { lo |= f << bit; if (bit > 58) hi |= (unsigned)(f >> (64 - bit)); } else hi |= (unsigned)f << (bit - 64); }
    d[0] = (unsigned)lo; d[1] = (unsigned)(lo >> 32); d[2] = hi;
}
__device__ __forceinline__ void phase_tables6(const Ctx& C, int l) {
    const float* su = C.a->in[I_PU] + (size_t)l * 16384 * 1024; const float* sv = C.a->in[I_PV] + (size_t)l * 16384 * 1024;
    unsigned char* T = WSP(unsigned char, B_TU);
    const long n = (long)16384 * 64;
    for (long i = (long)C.bid * NT + C.tid; i < n; i += (long)C.nb * NT) {
        const long e = i >> 6; const int ln = (int)(i & 63);
        float x[16], y[16];
#pragma unroll
        for (int k = 0; k < 4; ++k) { const f32x4 a = *(const f32x4*)(su + e * 1024 + 256 * k + 4 * ln), b = *(const f32x4*)(sv + e * 1024 + 256 * k + 4 * ln);
#pragma unroll
            for (int j = 0; j < 4; ++j) { x[4 * k + j] = a[j]; y[4 * k + j] = b[j]; } }
        unsigned du[3], dv[3]; fp6_pack16(x, T6U, du); fp6_pack16(y, T6V, dv);
        unsigned char* pu = T + e * 768; unsigned char* pv = WSP(unsigned char, B_TV) + e * 768;
        u32x2 w0, w1; w0.x = du[0]; w0.y = du[1]; w1.x = dv[0]; w1.y = dv[1];
        *(u32x2*)(pu + ln * 8) = w0; *(unsigned*)(pu + 512 + ln * 4) = du[2]; *(u32x2*)(pv + ln * 8) = w1; *(unsigned*)(pv + 512 + ln * 4) = dv[2]; }
}
__device__ __forceinline__ void tables6_part(const Ctx& C, int l, int e0, int e1, int j, int P) {
    const float* su = C.a->in[I_PU] + (size_t)l * 16384 * 1024; const float* sv = C.a->in[I_PV] + (size_t)l * 16384 * 1024;
    unsigned char* T = WSP(unsigned char, B_TU);
    const int ln = C.lane;
#pragma unroll 1
    for (long e = e0 + j * 8 + C.wave; e < e1; e += P * 8) {
        float x[16], y[16];
#pragma unroll
        for (int k = 0; k < 4; ++k) { const f32x4 a = *(const f32x4*)(su + e * 1024 + 256 * k + 4 * ln), b = *(const f32x4*)(sv + e * 1024 + 256 * k + 4 * ln);
#pragma unroll
            for (int jj = 0; jj < 4; ++jj) { x[4 * k + jj] = a[jj]; y[4 * k + jj] = b[jj]; } }
        unsigned du[3], dv[3]; fp6_pack16(x, T6U, du); fp6_pack16(y, T6V, dv);
        unsigned char* pu = T + e * 768; unsigned char* pv = WSP(unsigned char, B_TV) + e * 768;
        u32x2 w0, w1; w0.x = du[0]; w0.y = du[1]; w1.x = dv[0]; w1.y = dv[1];
        *(u32x2*)(pu + ln * 8) = w0; *(unsigned*)(pu + 512 + ln * 4) = du[2]; *(u32x2*)(pv + ln * 8) = w1; *(unsigned*)(pv + 512 + ln * 4) = dv[2]; }
}
__device__ __forceinline__ bool fp6_roundtrip_ok() {
    float x[16], y[16];
#pragma unroll
    for (int j = 0; j < 16; ++j) { x[j] = (j & 8) ? -(1.f + 0.125f * (float)(j & 7)) : 0.125f * (float)(j & 7); y[j] = ((j & 1) ? -1.f : 1.f) * ((j < 8) ? (2.f + 0.25f * (float)j) : (4.f + 0.5f * (float)(j - 8))); }
    unsigned du[3], dv[3]; fp6_pack16(x, 1.f, du); fp6_pack16(y, 1.f, dv);
    v6i w; w[0] = (int)du[0]; w[1] = (int)du[1]; w[2] = (int)du[2]; w[3] = (int)dv[0]; w[4] = (int)dv[1]; w[5] = (int)dv[2];
    const v32f r = __builtin_amdgcn_cvt_scalef32_pk32_f32_fp6(w, 1.0f);
    bool ok = true;
#pragma unroll
    for (int j = 0; j < 16; ++j) ok = ok && (r[j] == x[j]) && (r[16 + j] == y[j]);
    return ok;
}

#define PFMA(acc, x, y) asm("v_fmac_f32 %0, %1, %2" : "+v"(acc) : "v"(x), "v"(y))
__device__ __forceinline__ float gelu_fast(float x) { const float y2 = -2.3022081981244260f * (x + 0.044715f * x * x * x); return x * __builtin_amdgcn_rcpf(1.f + __builtin_amdgcn_exp2f(y2)); }

__device__ __forceinline__ void peer_sort_token(const Ctx& C, int tl) {
    const int lane = C.lane; const LAS unsigned char* rb = C.lds + (tl * 16) * PG_STRIDE;
    const int i0 = lane, i1 = lane + 64;
    const int e0 = *(const LAS int*)(rb + (2 * (i0 >> 4)) * PG_STRIDE + 4 * (i0 & 15)), e1 = *(const LAS int*)(rb + (2 * (i1 >> 4)) * PG_STRIDE + 4 * (i1 & 15));
    const unsigned g0 = *(const LAS unsigned*)(rb + (2 * (i0 >> 4) + 1) * PG_STRIDE + 4 * (i0 & 15)), g1 = *(const LAS unsigned*)(rb + (2 * (i1 >> 4) + 1) * PG_STRIDE + 4 * (i1 & 15));
    const int r0 = e0 >> 10, r1 = e1 >> 10; int base = 0, pos0 = 0, pos1 = 0;
#pragma unroll
    for (int r = 0; r < 16; ++r) { const unsigned long long b0 = __ballot(r0 == r), b1 = __ballot(r1 == r); const int c0 = __popcll(b0);
        const int m0 = (int)__builtin_amdgcn_mbcnt_hi((unsigned)(b0 >> 32), __builtin_amdgcn_mbcnt_lo((unsigned)b0, 0u)), m1 = (int)__builtin_amdgcn_mbcnt_hi((unsigned)(b1 >> 32), __builtin_amdgcn_mbcnt_lo((unsigned)b1, 0u));
        if (r0 == r) pos0 = base + m0;
        if (r1 == r) pos1 = base + c0 + m1;
        base += c0 + __popcll(b1); }
    u32x2 w0, w1; w0.x = (unsigned)e0; w0.y = g0; w1.x = (unsigned)e1; w1.y = g1;
    *(LAS u32x2*)(C.lds + (tl * 16 + (pos0 >> 4)) * PG_STRIDE + 64 + 8 * (pos0 & 15)) = w0;
    *(LAS u32x2*)(C.lds + (tl * 16 + (pos1 >> 4)) * PG_STRIDE + 64 + 8 * (pos1 & 15)) = w1;
}
typedef _Float16 v32h __attribute__((ext_vector_type(32)));
typedef _Float16 h2v __attribute__((ext_vector_type(2)));
__device__ __forceinline__ void peer_token6(const Ctx& C, int l, int m, int tl, bool dry) {
    const float* MOD = WSP(float, WS_MOD); bf16_t* H = WSP(bf16_t, WS_H);
    const unsigned char* TU6 = WSP(unsigned char, B_TU); const unsigned char* TV6 = WSP(unsigned char, B_TV);
    const float* g_ = C.a->in[I_LN2G] + l * 1024; const float* b_ = C.a->in[I_LN2B] + l * 1024;
    const int lane = C.lane;
    const unsigned lo8 = (unsigned)lane * 8u, lo4 = (unsigned)lane * 4u;
    const __amdgpu_buffer_rsrc_t rsU = __builtin_amdgcn_make_buffer_rsrc((void*)TU6, (short)0, 16384 * 768, 0x00020000), rsV = __builtin_amdgcn_make_buffer_rsrc((void*)TV6, (short)0, 16384 * 768, 0x00020000);
    float out[16]; h2v hh[8], oh[8];
    { float hv[16]; const u32x4* hp = (const u32x4*)(H + (size_t)m * 1024); unpack8(hp[2 * lane], hv); unpack8(hp[2 * lane + 1], hv + 8);
#pragma unroll
      for (int j = 0; j < 8; ++j) { hh[j][0] = (_Float16)hv[2 * j]; hh[j][1] = (_Float16)hv[2 * j + 1]; } }
#pragma unroll
    for (int i = 0; i < 16; ++i) out[i] = 0.f;
#pragma unroll
    for (int j = 0; j < 8; ++j) oh[j] = (h2v){(_Float16)0.f, (_Float16)0.f};
#pragma unroll 1
    for (int bi = 0; bi < 16; ++bi) {
        {
            const int idx_ = 8 * bi + (lane & 7); const u32x2 ent_ = *(const LAS u32x2*)(C.lds + (tl * 16 + (idx_ >> 4)) * PG_STRIDE + 64 + 8 * (idx_ & 15));
            const int ek = (int)ent_.x; const float gk = __uint_as_float(ent_.y); constexpr int half = 0;
            u32x2 ua[8], va[8]; unsigned ub[8], vb[8];
#pragma unroll
            for (int i = 0; i < 8; ++i) { const unsigned eo = __builtin_amdgcn_readfirstlane((unsigned)__builtin_amdgcn_readlane(ek, half * 8 + i) * 768u);
                ua[i] = __builtin_bit_cast(u32x2, __builtin_amdgcn_raw_buffer_load_b64(rsU, lo8, eo, 0)); ub[i] = __builtin_amdgcn_raw_buffer_load_b32(rsU, 512u + lo4, eo, 0);
                va[i] = __builtin_bit_cast(u32x2, __builtin_amdgcn_raw_buffer_load_b64(rsV, lo8, eo, 0)); vb[i] = __builtin_amdgcn_raw_buffer_load_b32(rsV, 512u + lo4, eo, 0); }
            __builtin_amdgcn_sched_barrier(0);
            float p[8];
#pragma unroll
            for (int i = 0; i < 8; i += 2) { v6i w; w[0] = (int)ua[i].x; w[1] = (int)ua[i].y; w[2] = (int)ub[i]; w[3] = (int)ua[i + 1].x; w[4] = (int)ua[i + 1].y; w[5] = (int)ub[i + 1];
                const v32h t = __builtin_amdgcn_cvt_scalef32_pk32_f16_fp6(w, 1.0f); h2v a = (h2v){(_Float16)0.f, (_Float16)0.f}, b = a;
#pragma unroll
                for (int j = 0; j < 8; ++j) { a = __builtin_elementwise_fma(hh[j], (h2v){t[2 * j], t[2 * j + 1]}, a); b = __builtin_elementwise_fma(hh[j], (h2v){t[16 + 2 * j], t[17 + 2 * j]}, b); }
                p[i] = (float)a[0] + (float)a[1]; p[i + 1] = (float)b[0] + (float)b[1]; __builtin_amdgcn_sched_barrier(0); }
            const float tsum = reduce8(p, lane);
            const int myx = ((lane >> 5) & 1) * 4 + ((lane >> 4) & 1) * 2 + ((lane >> 3) & 1);
            const float wl = __shfl(gk, half * 8 + myx) * gelu_fast(tsum * (1.f / T6U)) * (1.f / T6V);
            const h2v wl2 = (h2v){(_Float16)wl, (_Float16)wl};
            const int wlb = __builtin_bit_cast(int, wl2);
#pragma unroll
            for (int i = 0; i < 8; i += 2) {
                const h2v w0 = __builtin_bit_cast(h2v, __builtin_amdgcn_readlane(wlb, (i >> 2) * 32 + ((i >> 1) & 1) * 16 + (i & 1) * 8)), w1 = __builtin_bit_cast(h2v, __builtin_amdgcn_readlane(wlb, ((i + 1) >> 2) * 32 + (((i + 1) >> 1) & 1) * 16 + ((i + 1) & 1) * 8));
                v6i w; w[0] = (int)va[i].x; w[1] = (int)va[i].y; w[2] = (int)vb[i]; w[3] = (int)va[i + 1].x; w[4] = (int)va[i + 1].y; w[5] = (int)vb[i + 1];
                const v32h t = __builtin_amdgcn_cvt_scalef32_pk32_f16_fp6(w, 1.0f);
#pragma unroll
                for (int j = 0; j < 8; ++j) oh[j] = __builtin_elementwise_fma(w0, (h2v){t[2 * j], t[2 * j + 1]}, oh[j]);
#pragma unroll
                for (int j = 0; j < 8; ++j) oh[j] = __builtin_elementwise_fma(w1, (h2v){t[16 + 2 * j], t[17 + 2 * j]}, oh[j]);
                __builtin_amdgcn_sched_barrier(0); }
        }
        if ((bi & 3) == 3) {
#pragma unroll
            for (int j = 0; j < 8; ++j) { out[2 * j] += (float)oh[j][0]; out[2 * j + 1] += (float)oh[j][1]; oh[j] = (h2v){(_Float16)0.f, (_Float16)0.f}; } }
    }
    float* xo = xrow_out(C, m); float* xw = dry ? WSP(float, B_VN) + (size_t)(C.bid * 8 + C.wave) * 1024 : xo; bf16_t* hw = dry ? WSP(bf16_t, B_VN + 16 * MiB) + (size_t)(C.bid * 8 + C.wave) * 1024 : H + (size_t)m * 1024;
    const float* md = MOD + (size_t)(l * 9 + mod_index(m)) * 6144;
    float v[16]; float s = 0.f;
#pragma unroll
    for (int q4 = 0; q4 < 4; ++q4) { const int col = 16 * lane + 4 * q4; const f32x4 x = *(const f32x4*)(xo + col), g2 = *(const f32x4*)(md + 5120 + col);
#pragma unroll
        for (int j = 0; j < 4; ++j) { const float t = ALPHA * x[j] + g2[j] * out[q4 * 4 + j]; v[q4 * 4 + j] = t; s += t; } }
    const float mu = wave_sum(s) * (1.f / 1024.f); float q = 0.f;
#pragma unroll
    for (int j = 0; j < 16; ++j) { v[j] -= mu; q += v[j] * v[j]; }
    const float rs = rsqrtf(wave_sum(q) * (1.f / 1024.f) + LN_EPS);
    const float* mdn = MOD + (size_t)((l + 1) * 9 + mod_index(m)) * 6144;
    float hn[16];
#pragma unroll
    for (int q4 = 0; q4 < 4; ++q4) { const int col = 16 * lane + 4 * q4; const f32x4 gg = *(const f32x4*)(g_ + col), bb = *(const f32x4*)(b_ + col); f32x4 x2;
#pragma unroll
        for (int j = 0; j < 4; ++j) x2[j] = v[q4 * 4 + j] * rs * gg[j] + bb[j];
        *(f32x4*)(xw + col) = x2;
        if (l == 0) { const f32x4 sh = *(const f32x4*)(mdn + col), sc = *(const f32x4*)(mdn + 1024 + col);
#pragma unroll
            for (int j = 0; j < 4; ++j) hn[q4 * 4 + j] = x2[j] * (1.f + sc[j]) + sh[j]; } }
    if (l == 0) { u32x4 w0, w1; w0.x = pk2(hn[0], hn[1]); w0.y = pk2(hn[2], hn[3]); w0.z = pk2(hn[4], hn[5]); w0.w = pk2(hn[6], hn[7]);
        w1.x = pk2(hn[8], hn[9]); w1.y = pk2(hn[10], hn[11]); w1.z = pk2(hn[12], hn[13]); w1.w = pk2(hn[14], hn[15]);
        u32x4* hp = (u32x4*)hw; hp[2 * lane] = w0; hp[2 * lane + 1] = w1; }
}

__device__ __forceinline__ void peer_ln2(const Ctx& C, int l, int m, const h2v (&oh)[8], const f32x4 (&xin)[4], bool dry) {
    const float* MOD = WSP(float, WS_MOD); bf16_t* H = WSP(bf16_t, WS_H);
    const float* g_ = C.a->in[I_LN2G] + l * 1024; const float* b_ = C.a->in[I_LN2B] + l * 1024;
    const int lane = C.lane;
    float out[16];
#pragma unroll
    for (int j = 0; j < 8; ++j) { out[2 * j] = (float)oh[j][0]; out[2 * j + 1] = (float)oh[j][1]; }
    float* xo = xrow_out(C, m); float* xw = dry ? WSP(float, B_VN) + (size_t)(C.bid * 8 + C.wave) * 1024 : xo; bf16_t* hw = dry ? WSP(bf16_t, B_VN + 16 * MiB) + (size_t)(C.bid * 8 + C.wave) * 1024 : H + (size_t)m * 1024;
    const float* md = MOD + (size_t)(l * 9 + mod_index(m)) * 6144;
    float v[16]; float s = 0.f;
#pragma unroll
    for (int q4 = 0; q4 < 4; ++q4) { const int col = 256 * q4 + 4 * lane; const f32x4 x = xin[q4], g2 = *(const f32x4*)(md + 5120 + col);
#pragma unroll
        for (int j = 0; j < 4; ++j) { const float t = ALPHA * x[j] + g2[j] * out[q4 * 4 + j]; v[q4 * 4 + j] = t; s += t; } }
    const float mu = wave_sum(s) * (1.f / 1024.f); float q = 0.f;
#pragma unroll
    for (int j = 0; j < 16; ++j) { v[j] -= mu; q += v[j] * v[j]; }
    const float rs = rsqrtf(wave_sum(q) * (1.f / 1024.f) + LN_EPS);
    const float* mdn = MOD + (size_t)((l + 1) * 9 + mod_index(m)) * 6144;
    float hn[16];
#pragma unroll
    for (int q4 = 0; q4 < 4; ++q4) { const int col = 256 * q4 + 4 * lane; const f32x4 gg = *(const f32x4*)(g_ + col), bb = *(const f32x4*)(b_ + col); f32x4 x2;
#pragma unroll
        for (int j = 0; j < 4; ++j) x2[j] = v[q4 * 4 + j] * rs * gg[j] + bb[j];
        if (l == 0 && !dry) { u32x2 wx; wx.x = pk2(x2[0], x2[1]); wx.y = pk2(x2[2], x2[3]); *(u32x2*)(xd_row(C, m) + col) = wx; } else *(f32x4*)(xw + col) = x2;
        if (l == 0) { const f32x4 sh = *(const f32x4*)(mdn + col), sc = *(const f32x4*)(mdn + 1024 + col);
#pragma unroll
            for (int j = 0; j < 4; ++j) hn[q4 * 4 + j] = x2[j] * (1.f + sc[j]) + sh[j]; } }
    if (l == 0) {
#pragma unroll
        for (int q4 = 0; q4 < 4; ++q4) { u32x2 w; w.x = pk2(hn[4 * q4], hn[4 * q4 + 1]); w.y = pk2(hn[4 * q4 + 2], hn[4 * q4 + 3]); *(u32x2*)(hw + 256 * q4 + 4 * lane) = w; } }
}
__device__ __forceinline__ void peer_batch(int ek, float gk, const h2v (&hh)[8], h2v (&oh)[8], const __amdgpu_buffer_rsrc_t rsU, const __amdgpu_buffer_rsrc_t rsV, unsigned lo8, unsigned lo4, int lane) {
    u32x2 ua[8], va[8]; unsigned ub[8], vb[8];
#pragma unroll
    for (int i = 0; i < 8; ++i) { const unsigned eo = __builtin_amdgcn_readfirstlane((unsigned)__builtin_amdgcn_readlane(ek, i) * 768u);
        ua[i] = __builtin_bit_cast(u32x2, __builtin_amdgcn_raw_buffer_load_b64(rsU, lo8, eo, 0)); ub[i] = __builtin_amdgcn_raw_buffer_load_b32(rsU, 512u + lo4, eo, 0);
        va[i] = __builtin_bit_cast(u32x2, __builtin_amdgcn_raw_buffer_load_b64(rsV, lo8, eo, 0)); vb[i] = __builtin_amdgcn_raw_buffer_load_b32(rsV, 512u + lo4, eo, 0); }
    __builtin_amdgcn_sched_barrier(0);
    float p[8];
#pragma unroll
    for (int i = 0; i < 8; i += 2) { v6i w; w[0] = (int)ua[i].x; w[1] = (int)ua[i].y; w[2] = (int)ub[i]; w[3] = (int)ua[i + 1].x; w[4] = (int)ua[i + 1].y; w[5] = (int)ub[i + 1];
        const v32h t = __builtin_amdgcn_cvt_scalef32_pk32_f16_fp6(w, 1.0f); float a = 0.f, b = 0.f;
#pragma unroll
        for (int j = 0; j < 8; ++j) { a = __builtin_amdgcn_fdot2(hh[j], (h2v){t[2 * j], t[2 * j + 1]}, a, false); b = __builtin_amdgcn_fdot2(hh[j], (h2v){t[16 + 2 * j], t[17 + 2 * j]}, b, false); }
        p[i] = a; p[i + 1] = b; }
    const float tsum = reduce8(p, lane);
    const float wl = gk * gelu_fast(tsum * (1.f / T6U)) * (1.f / T6V);
    const int wlb = __builtin_bit_cast(int, (h2v){(_Float16)wl, (_Float16)wl});
#pragma unroll
    for (int i = 0; i < 8; i += 2) {
        const h2v w0 = __builtin_bit_cast(h2v, __builtin_amdgcn_readlane(wlb, 9 * i)), w1 = __builtin_bit_cast(h2v, __builtin_amdgcn_readlane(wlb, 9 * (i + 1)));
        v6i w; w[0] = (int)va[i].x; w[1] = (int)va[i].y; w[2] = (int)vb[i]; w[3] = (int)va[i + 1].x; w[4] = (int)va[i + 1].y; w[5] = (int)vb[i + 1];
        const v32h t = __builtin_amdgcn_cvt_scalef32_pk32_f16_fp6(w, 1.0f);
#pragma unroll
        for (int j = 0; j < 8; ++j) oh[j] = __builtin_elementwise_fma(w0, (h2v){t[2 * j], t[2 * j + 1]}, oh[j]);
#pragma unroll
        for (int j = 0; j < 8; ++j) oh[j] = __builtin_elementwise_fma(w1, (h2v){t[16 + 2 * j], t[17 + 2 * j]}, oh[j]);
        }
}

__device__ __forceinline__ void peer_tokens4(const Ctx& C, int l, int t0, int nt, bool dry) {
    bf16_t* H = WSP(bf16_t, WS_H);
    const unsigned char* TU6 = WSP(unsigned char, B_TU); const unsigned char* TV6 = WSP(unsigned char, B_TV);
    const int lane = C.lane; const unsigned lo8 = (unsigned)lane * 8u, lo4 = (unsigned)lane * 4u;
    const __amdgpu_buffer_rsrc_t rsU = __builtin_amdgcn_make_buffer_rsrc((void*)TU6, (short)0, 16384 * 768, 0x00020000), rsV = __builtin_amdgcn_make_buffer_rsrc((void*)TV6, (short)0, 16384 * 768, 0x00020000);
    const bool quad = nt <= 8;
    h2v hh[4][8], oh[4][8];
#pragma unroll
    for (int k = 0; k < 4; ++k) { const int tl = quad ? C.wave : C.wave + 8 * k;
#pragma unroll
        for (int j = 0; j < 8; ++j) { hh[k][j] = (h2v){(_Float16)0.f, (_Float16)0.f}; oh[k][j] = hh[k][j]; }
        if (tl < nt) { const bf16_t* hp = H + (size_t)(t0 + tl) * 1024 + 4 * lane;
#pragma unroll
            for (int q4 = 0; q4 < 4; ++q4) { const u32x2 w = *(const u32x2*)(hp + 256 * q4);
                hh[k][2 * q4][0] = (_Float16)lo16(w.x); hh[k][2 * q4][1] = (_Float16)hi16(w.x); hh[k][2 * q4 + 1][0] = (_Float16)lo16(w.y); hh[k][2 * q4 + 1][1] = (_Float16)hi16(w.y); } } }
    const int nbi = quad ? 4 : 16;
#pragma unroll 1
    for (int bi = 0; bi < nbi; ++bi) {
#pragma unroll
        for (int k = 0; k < 4; ++k) { const int tl = quad ? C.wave : C.wave + 8 * k;
            if (tl < nt) { const int idx = 8 * (quad ? 4 * k + bi : bi) + (lane & 7); const u32x2 ent = *(const LAS u32x2*)(C.lds + (tl * 16 + (idx >> 4)) * PG_STRIDE + 64 + 8 * (idx & 15));
                peer_batch((int)ent.x, __uint_as_float(ent.y), hh[k], oh[k], rsU, rsV, lo8, lo4, lane); } } }
    if (quad) {
#pragma unroll
        for (int j = 0; j < 8; ++j) oh[0][j] = (oh[0][j] + oh[1][j]) + (oh[2][j] + oh[3][j]); }
    f32x4 xr[4][4];
#pragma unroll
    for (int k = 0; k < 4; ++k) { const int tl = quad ? (k == 0 ? C.wave : nt) : C.wave + 8 * k;
#pragma unroll
        for (int q4 = 0; q4 < 4; ++q4) xr[k][q4] = (f32x4){0.f, 0.f, 0.f, 0.f};
        if (tl < nt) { const bf16_t* xo = xb_row(C, t0 + tl);
#pragma unroll
            for (int q4 = 0; q4 < 4; ++q4) { const u32x2 xx = __builtin_nontemporal_load((const u32x2*)(xo + 256 * q4 + 4 * lane)); xr[k][q4][0] = lo16(xx.x); xr[k][q4][1] = hi16(xx.x); xr[k][q4][2] = lo16(xx.y); xr[k][q4][3] = hi16(xx.y); } } }
#pragma unroll
    for (int k = 0; k < 4; ++k) { const int tl = quad ? (k == 0 ? C.wave : nt) : C.wave + 8 * k; if (tl < nt) peer_ln2(C, l, t0 + tl, oh[k], xr[k], dry); }
}

__device__ __forceinline__ void phase_peer2(const Ctx& C, int l, bool dry) {
    const unsigned char* S = WSP(unsigned char, B_S);
    const int rows_total = (l == 0) ? M_ALL : M_LAT;
    const int rpb = (((rows_total + C.nb - 1) / C.nb) + 7) & ~7;
    const int rbeg = C.bid * rpb, rend = min(rows_total, rbeg + rpb);
    for (int t0 = rbeg; t0 < rend; t0 += 32) {
        const int nt = min(32, rend - t0);
        for (int c0 = C.tid; c0 < nt * 256; c0 += 4 * NT) {
            u32x4 w[4];
#pragma unroll
            for (int i = 0; i < 4; ++i) { const int c = c0 + i * NT; w[i] = __builtin_nontemporal_load((const u32x4*)(S + (size_t)(t0 + (c >> 8)) * 4096 + (c & 255) * 16)); }
#pragma unroll
            for (int i = 0; i < 4; ++i) { const int c = c0 + i * NT; const int tl = c >> 8, cc = c & 255; *(LAS u32x4*)(C.lds + (tl * 16 + (cc >> 4)) * PG_STRIDE + (cc & 15) * 16) = w[i]; } }
        __syncthreads();
        if (C.tid < nt * 16) {
            LAS unsigned char* gp = C.lds + C.tid * PG_STRIDE;
            unsigned list[16];
#pragma unroll
            for (int p = 0; p < 16; ++p) list[p] = 0u;
#pragma unroll 1
            for (int c = 0; c < 8; ++c) { const u32x4 w0 = *(const LAS u32x4*)(gp + 32 * c), w1 = *(const LAS u32x4*)(gp + 32 * c + 16); unsigned nw[16]; const int ib = 16 * c;
                nw[0] = key_h(w0.x & 0xffffu, ib + 0); nw[1] = key_h(w0.x >> 16, ib + 1); nw[2] = key_h(w0.y & 0xffffu, ib + 2); nw[3] = key_h(w0.y >> 16, ib + 3);
                nw[4] = key_h(w0.z & 0xffffu, ib + 4); nw[5] = key_h(w0.z >> 16, ib + 5); nw[6] = key_h(w0.w & 0xffffu, ib + 6); nw[7] = key_h(w0.w >> 16, ib + 7);
                nw[8] = key_h(w1.x & 0xffffu, ib + 8); nw[9] = key_h(w1.x >> 16, ib + 9); nw[10] = key_h(w1.y & 0xffffu, ib + 10); nw[11] = key_h(w1.y >> 16, ib + 11);
                nw[12] = key_h(w1.z & 0xffffu, ib + 12); nw[13] = key_h(w1.z >> 16, ib + 13); nw[14] = key_h(w1.w & 0xffffu, ib + 14); nw[15] = key_h(w1.w >> 16, ib + 15);
                sort16_desc(nw); merge16_desc(list, nw); }
#pragma unroll
            for (int p = 0; p < 4; ++p) { u32x4 w; w.x = list[4 * p]; w.y = list[4 * p + 1]; w.z = list[4 * p + 2]; w.w = list[4 * p + 3]; *(LAS u32x4*)(gp + 16 * p) = w; }
        }
        __syncthreads();
        if (C.tid < nt * 8) {
            LAS unsigned char* rA = C.lds + (C.tid * 2) * PG_STRIDE; LAS unsigned char* rB = rA + PG_STRIDE;
            float sa[16], sb[16];
#pragma unroll
            for (int p = 0; p < 4; ++p) { const u32x4 a = *(const LAS u32x4*)(rA + 16 * p), b = *(const LAS u32x4*)(rB + 16 * p);
                sa[4 * p] = dec16(a.x); sa[4 * p + 1] = dec16(a.y); sa[4 * p + 2] = dec16(a.z); sa[4 * p + 3] = dec16(a.w);
                sb[4 * p] = dec16(b.x); sb[4 * p + 1] = dec16(b.y); sb[4 * p + 2] = dec16(b.z); sb[4 * p + 3] = dec16(b.w); }
            unsigned cl[16];
#pragma unroll
            for (int p = 0; p < 16; ++p) cl[p] = 0u;
#pragma unroll
            for (int i = 0; i < 16; ++i)
#pragma unroll
                for (int j = 0; j < 16; ++j) if ((i + 1) * (j + 1) <= 16) ins16(cl, (ordf(sa[i] + sb[j]) & ~255u) | (unsigned)(255 - (i * 16 + j)));
            int e[16]; float sc[16];
#pragma unroll
            for (int k = 0; k < 16; ++k) { const unsigned pij = 255u - (cl[k] & 255u); const unsigned ka = *(const LAS unsigned*)(rA + 4 * (pij >> 4)), kb = *(const LAS unsigned*)(rB + 4 * (pij & 15));
                e[k] = (int)((127u - (ka & 127u)) * 128u + (127u - (kb & 127u))); sc[k] = dec16(ka) + dec16(kb); }
            const float mx = sc[0]; float den = 0.f;
#pragma unroll
            for (int k = 0; k < 16; ++k) { sc[k] = __expf(sc[k] - mx); den += sc[k]; }
            const float inv = 1.f / den;
#pragma unroll
            for (int p = 0; p < 4; ++p) { u32x4 w; w.x = (unsigned)e[4 * p]; w.y = (unsigned)e[4 * p + 1]; w.z = (unsigned)e[4 * p + 2]; w.w = (unsigned)e[4 * p + 3]; *(LAS u32x4*)(rA + 16 * p) = w;
                f32x4 g; g[0] = sc[4 * p] * inv; g[1] = sc[4 * p + 1] * inv; g[2] = sc[4 * p + 2] * inv; g[3] = sc[4 * p + 3] * inv; *(LAS f32x4*)(rB + 16 * p) = g; }
        }
        __syncthreads();
#pragma unroll 1
        for (int k = 0; k < 4; ++k) { const int tl = C.wave + 8 * k; if (tl >= nt) break; peer_sort_token(C, tl); }
        wave_sync();
        peer_tokens4(C, l, t0, nt, dry);
        __syncthreads();
    }
}


constexpr size_t WS_CTL = 45 * MiB + 512 * 1024;
constexpr int LDS_BAR_OFF = 147392;
#define XB_TMO      128
#define XB_XCNT(j)  (256  + 64 * (j))
#define XB_XSUB(j)  (1280 + 64 * (j))
#define XB_XGEN(j)  (2304 + 64 * (j))
#define XB_TOP      3328
#define XB_TOPGEN   3392
#define XCD_BAR_WORDS 3456
#define XB_SPIN_CAP (1u << 23)
__device__ __forceinline__ unsigned xb_ld(unsigned* p)              { return __hip_atomic_load(p, __ATOMIC_RELAXED, __HIP_MEMORY_SCOPE_AGENT); }
__device__ __forceinline__ unsigned xb_add(unsigned* p, unsigned v) { return __hip_atomic_fetch_add(p, v, __ATOMIC_RELAXED, __HIP_MEMORY_SCOPE_AGENT); }
__device__ __forceinline__ unsigned xb_xcc_id() { return (unsigned)__builtin_amdgcn_s_getreg((3 << 11) | 20) & 0xFu; }
#define XB_SPIN(cond, bar) do { unsigned _sp = 0; while (cond) { __builtin_amdgcn_s_sleep(1); \
    if ((++_sp & 255u) == 0u) { if (xb_ld(&(bar)[XB_TMO])) break; if (_sp > XB_SPIN_CAP) { atomicAdd(&(bar)[XB_TMO], 1u); break; } } } } while (0)
struct XcdBarrier { unsigned* bar; unsigned x; volatile LAS unsigned* st; bool tid0; };
__device__ __forceinline__ XcdBarrier xcd_barrier_post(unsigned* bar, volatile LAS unsigned* st, bool tid0) {
    XcdBarrier b; b.bar = bar; b.x = xb_xcc_id(); b.st = st; b.tid0 = tid0;
    if (b.tid0) (void)xb_add(&bar[XB_XCNT(b.x)], 1u);
    return b;
}
__device__ __forceinline__ void xcd_barrier_complete(unsigned* bar, unsigned x, unsigned& nloc, unsigned& nx) {
    const unsigned G = gridDim.x * gridDim.y * gridDim.z;
    unsigned sum, cnt, mine, sp = 0u;
    for (;;) {
        sum = 0u; cnt = 0u; mine = 0u;
#pragma unroll
        for (unsigned j = 0; j < 16; ++j) { const unsigned c = xb_ld(&bar[XB_XCNT(j)]); sum += c; cnt += (c > 0u) ? 1u : 0u; mine = (j == x) ? c : mine; }
        if (sum == G) break;
        __builtin_amdgcn_s_sleep(1);
        if ((++sp & 255u) == 0u) { if (xb_ld(&bar[XB_TMO])) break; if (sp > XB_SPIN_CAP) { atomicAdd(&bar[XB_TMO], 1u); break; } }
    }
    nloc = mine > 0u ? mine : 1u; nx = cnt > 0u ? cnt : 1u;
}
__device__ __forceinline__ void xcd_barrier(const XcdBarrier& b) {
    asm volatile("s_waitcnt vmcnt(0)" ::: "memory");
    __syncthreads();
    if (b.tid0) {
        unsigned* bar = b.bar;
        __builtin_amdgcn_s_waitcnt(0);
        unsigned nloc = b.st[0], nx = b.st[1];
        if (nloc == 0u) { xcd_barrier_complete(bar, b.x, nloc, nx); b.st[0] = nloc; b.st[1] = nx; }
        const unsigned old = xb_add(&bar[XB_XSUB(b.x)], 1u);
        const unsigned gen = old / nloc;
        if (old + 1u == (gen + 1u) * nloc) {
            __builtin_amdgcn_fence(__ATOMIC_RELEASE, "agent");
            asm volatile("s_waitcnt vmcnt(0)" ::: "memory");
            const unsigned og = xb_add(&bar[XB_TOP], 1u);
            const unsigned tg = og / nx;
            if (og + 1u == (tg + 1u) * nx) xb_add(&bar[XB_TOPGEN], 1u);
            else XB_SPIN(xb_ld(&bar[XB_TOPGEN]) == tg, bar);
            __builtin_amdgcn_fence(__ATOMIC_ACQUIRE, "agent");
            xb_add(&bar[XB_XGEN(b.x)], 1u);
            asm volatile("s_waitcnt vmcnt(0)" ::: "memory");
        } else {
            XB_SPIN(xb_ld(&bar[XB_XGEN(b.x)]) == gen, bar);
            __builtin_amdgcn_fence(__ATOMIC_ACQUIRE, "agent");
            asm volatile("s_waitcnt vmcnt(0)" ::: "memory");
        }
    }
    __syncthreads();
}

constexpr int LDS_BYTES = 147456;
constexpr int PH_PER_LAYER = 10, N_PHASES = 2 + 2 * PH_PER_LAYER;

__device__ __forceinline__ int lane_now() { int l; asm volatile("v_mbcnt_lo_u32_b32 %0, -1, 0\n\tv_mbcnt_hi_u32_b32 %0, -1, %0" : "=v"(l)); return l; }
__global__ void __launch_bounds__(NT, 2) mega(Args args) {
    extern __shared__ __attribute__((aligned(16))) unsigned char lds_raw[];
    cg::grid_group grid = cg::this_grid();
    Ctx C; C.lds = (LAS unsigned char*)lds_raw; C.bid = blockIdx.x; C.nb = gridDim.x;
    volatile LAS unsigned* bst = (volatile LAS unsigned*)(C.lds + LDS_BAR_OFF);
    const int wv0 = __builtin_amdgcn_readfirstlane((int)(threadIdx.x >> 6));
    { const int t0 = wv0 * 64 + lane_now(); if (t0 < 4) bst[t0] = 0u;
      __syncthreads();
      (void)xcd_barrier_post((unsigned*)(args.ws + WS_CTL), bst, t0 == 0); }
#ifndef FUSE_M1
#define FUSE_M1 1
#endif
#ifndef TAILTAB
#define TAILTAB 1
#endif
#ifndef PH_MASK
#define PH_MASK 0xFFFFFFFFu
#endif
#define EN(k) ((PH_MASK >> (k)) & 1u)
#ifndef DBL_MASK
#define DBL_MASK 0u
#endif
#define REP(k) for (int rep_ = 0; rep_ < 1 + (int)((DBL_MASK >> (k)) & 1u); ++rep_)
    const int lo = args.ph_lo, hi = args.ph_hi;
#ifndef DBLQ_MASK
#define DBLQ_MASK 0u
#endif
    bool again_ = false;
    for (int ph = lo; ph < hi; ++ph) {
        if (FUSE_M1 && ph >= 2 && (ph - 2) % PH_PER_LAYER == 4) continue;
        if (ph > lo) { if (ph == lo + 1) grid.sync(); else { ArgsP ap2 = (ArgsP)__builtin_amdgcn_kernarg_segment_ptr(); asm volatile("" : "+s"(ap2));
            XcdBarrier xb; xb.bar = (unsigned*)(ap2->ws + WS_CTL); xb.x = xb_xcc_id(); xb.st = (volatile LAS unsigned*)(C.lds + LDS_BAR_OFF); xb.tid0 = (wv0 * 64 + lane_now()) == 0; xcd_barrier(xb); } }
        { ArgsP ap = (ArgsP)__builtin_amdgcn_kernarg_segment_ptr(); asm volatile("" : "+s"(ap)); C.a = ap; C.ws = ap->ws; C.wave = wv0; }
#define CTX_TID() do { const int t_ = wv0 * 64 + lane_now(); C.tid = t_; C.lane = t_ & 63; } while (0)
        if (ph == 0) { CTX_TID(); if (EN(10)) REP(16) { phase_mod(C); __syncthreads(); phase_convert(C); __syncthreads(); phase_fold(C); phase_wsb(C); phase_rope_tab(C); __syncthreads(); } continue; }
        if (ph == 1) { CTX_TID(); if (EN(11)) REP(17) phase_h0(C); continue; }
        const int l = (ph - 2) / PH_PER_LAYER, q = (ph - 2) % PH_PER_LAYER;
        unsigned char* wl = C.ws + WS_W + (size_t)l * W_LAYER;
        switch (q) {
        case 0: CTX_TID(); if (EN(0)) REP(0) { pg8::Gemm g{WSP(bf16_t, WS_H), (const bf16_t*)(wl + W_WIN), 1024, 1024, 1024, 1 << 20, 0}; pg8::StaticOrder S; S.init(M_ALL / 256, ZP / 256, C.nb, C.bid);
                  pg8::EpiBf16T<2> E{WSP(bf16_t, B_Z), ZP}; pg8::gemm_phase<pg8::EpiBf16T<2>, true>(C.lds, C.tid, g, S, E); } break;
        case 1: CTX_TID(); if (EN(1)) { REP(10) { phase_gla_a2(C, l); __syncthreads(); } REP(11) phase_na2(C, l); REP(12) phase_conv2(C, l); REP(13) { phase_sgu(C, l); } } break;
        case 2: CTX_TID(); if (EN(2)) phase_gla_scan2(C); break;
        case 3: CTX_TID(); if (EN(3)) { REP(14) { phase_gla_out2(C, l); } } break;
        case 4: CTX_TID(); if (EN(4) && !FUSE_M1) REP(4) { pg8::Gemm g{WSP(bf16_t, WS_Y), (const bf16_t*)(wl + W_WB), 1024, 256, 256, 4, 256}; pg8::StaticOrder S; S.init(l == 0 ? M_ALL / 256 : M_LAT / 256, 16, C.nb, C.bid);
                  pg8::EpiBf16T<1> E{WSP(bf16_t, B_P), 4096}; pg8::gemm_phase<pg8::EpiBf16T<1>, true>(C.lds, C.tid, g, S, E); } break;
        case 5: CTX_TID(); if (EN(5)) REP(5) {
#if FUSE_M1
                  pg8::FusedArgs fa{WSP(bf16_t, WS_H), (const bf16_t*)(wl + W_WG), WSP(bf16_t, WS_Y), (const bf16_t*)(wl + W_WB), WSP(bf16_t, B_P)};
                  pg8::StaticOrder S; S.init(l == 0 ? M_ALL / 256 : M_LAT / 256, 16, C.nb, C.bid);
                  pg8::gemm_gates_fused(C.lds, C.tid, fa, S);
                  if (TAILTAB && l == 0 && C.bid >= 128) tables6_part(C, 0, 0, 5328, C.bid - 128, 128); } break;
#else
 pg8::Gemm g{WSP(bf16_t, WS_H), (const bf16_t*)(wl + W_WG), 1024, 1024, 1024, 1 << 20, 0}; pg8::StaticOrder S; S.init(l == 0 ? M_ALL / 256 : M_LAT / 256, 16, C.nb, C.bid, 1);
                  pg8::EpiMerge E{WSP(bf16_t, B_P), WSP(bf16_t, WS_Y)}; pg8::gemm_phase<pg8::EpiMerge, true>(C.lds, C.tid, g, S, E); } break;
#endif
        case 6: CTX_TID(); if (EN(6)) REP(6) { pg8::Gemm g{FUSE_M1 ? WSP(bf16_t, B_P) : WSP(bf16_t, WS_Y), (const bf16_t*)(wl + W_WO), 1024, 1024, 1024, 1 << 20, 0}; pg8::StaticOrder S; S.init(l == 0 ? M_ALL / 256 : M_LAT / 256, 4, C.nb, C.bid);
                  pg8::EpiBf16T<1> E{WSP(bf16_t, WS_H), 1024}; pg8::gemm_phase<pg8::EpiBf16T<1>, true>(C.lds, C.tid, g, S, E);
                  if (TAILTAB && l == 0 && C.bid >= 32) tables6_part(C, 0, 5328, 11136, C.bid - 32, 224); } break;
        case 7: CTX_TID(); if (EN(7)) { phase_ln1(C, l); if (!(TAILTAB && l == 0)) REP(7) phase_tables6(C, l); } break;
        case 8: CTX_TID(); if (EN(8)) REP(8) { pg8::Gemm g{WSP(bf16_t, WS_H), (const bf16_t*)(wl + W_WS), 1024, 1024, 1024, 1 << 20, 0}; pg8::StaticOrder S; S.init(l == 0 ? M_ALL / 256 : M_LAT / 256, 8, C.nb, C.bid);
                  pg8::EpiF16 E{WSP(unsigned short, B_S), 2048}; pg8::gemm_phase<pg8::EpiF16, true>(C.lds, C.tid, g, S, E);
                  if (TAILTAB && l == 0 && C.bid >= 64) tables6_part(C, 0, 11136, 16384, C.bid - 64, 192); } break;
        case 9: CTX_TID(); if (EN(9)) { REP(9) phase_peer2(C, l, (DBL_MASK >> 9) & 1u ? rep_ == 0 : false); } break;
        default: break;
        }
        if (ph == N_PHASES - 1 && C.bid == 0 && (wv0 * 64 + lane_now()) == 0 && !fp6_roundtrip_ok()) { ArgsP ap3 = (ArgsP)__builtin_amdgcn_kernarg_segment_ptr(); ap3->out[0] = __builtin_nanf(""); }
        if (DBLQ_MASK != 0u) { if (!again_ && ((DBLQ_MASK >> q) & 1u)) { again_ = true; --ph; } else again_ = false; }
    }
}

extern "C" void kernel_launch(void* const* d_in, const int* in_sizes, int n_in, void* d_out, int out_size, void* d_ws, size_t ws_size, hipStream_t stream) {
    static int grid = 0;
    if (grid == 0) {
        if (n_in != 29 || out_size != M_LAT * DM || ws_size < WS_NEED) { fprintf(stderr, "kernel_launch: unexpected shapes (n_in %d, out %d, ws %zu < %zu)\n", n_in, out_size, ws_size, (size_t)WS_NEED); grid = -1; return; }
        int dev = 0, cus = 0, per_cu = 0;
        hipGetDevice(&dev); hipDeviceGetAttribute(&cus, hipDeviceAttributeMultiprocessorCount, dev);
        if (hipFuncSetAttribute((const void*)mega, hipFuncAttributeMaxDynamicSharedMemorySize, LDS_BYTES) != hipSuccess) { fprintf(stderr, "kernel_launch: hipFuncSetAttribute failed\n"); grid = -1; return; }
        if (hipOccupancyMaxActiveBlocksPerMultiprocessor(&per_cu, (const void*)mega, NT, LDS_BYTES) != hipSuccess || per_cu < 1) { fprintf(stderr, "kernel_launch: occupancy query failed (%d)\n", per_cu); (void)hipGetLastError(); per_cu = 1; }
        grid = cus * 1;
        fprintf(stderr, "kernel_launch: cus %d per_cu %d grid %d ws %zu\n", cus, per_cu, grid, ws_size);
    }
    if (grid < 0) return;
    if (hipMemsetAsync((char*)d_ws + WS_CTL, 0, 16384, stream) != hipSuccess) { fprintf(stderr, "kernel_launch: memset failed\n"); return; }
    Args a{};
    for (int i = 0; i < 29; ++i) a.in[i] = (const float*)d_in[i];
    a.out = (float*)d_out; a.ws = (unsigned char*)d_ws;
#ifndef SINGLE_LAUNCH
#define SINGLE_LAUNCH 1
#endif
    if (SINGLE_LAUNCH) {
        a.ph_lo = 0; a.ph_hi = N_PHASES; void* kargs[] = {&a};
        hipError_t e = hipLaunchCooperativeKernel((void*)mega, dim3(grid), dim3(NT), kargs, LDS_BYTES, stream);
        if (e != hipSuccess) fprintf(stderr, "cooperative launch failed: %s\n", hipGetErrorString(e));
    } else {
        for (int ph = 0; ph < N_PHASES; ++ph) {
            a.ph_lo = ph; a.ph_hi = ph + 1; void* kargs[] = {&a};
            hipError_t e = hipLaunchCooperativeKernel((void*)mega, dim3(grid), dim3(NT), kargs, LDS_BYTES, stream);
            if (e != hipSuccess) { fprintf(stderr, "cooperative launch (phase %d) failed: %s\n", ph, hipGetErrorString(e)); break; }
        }
    }
}
```
